# Optimizing an MI355X kernel written in HIP

```python
import jax, jax.numpy as jnp
from jax import lax
import numpy as np

D_MODEL = 1024
BATCH = 2
SEQ = 8192
DEPTH = 4

D_MIX = D_MODEL
HEAD_DIM = 64
A_HEADS = 4
A_WIDTH = A_HEADS * HEAD_DIM
A_CHUNK = 128
B_HEADS = 8
B_DK = 64
B_DV = 64
B_WIDTH = B_HEADS * B_DV
B_CONV = 4
B_CHUNK = 64
C_HEADS = 4
C_DK = 32
C_DV = 64
C_KEY = C_HEADS * C_DK
C_WIDTH = C_HEADS * C_DV
C_RANK = 16
C_TAU = 16.0
C_CHUNK = 64
D_FF = 2816
ALPHA = (2.0 * DEPTH) ** 0.25
BETA_INIT = (8.0 * DEPTH) ** -0.25
EPS = 1e-5
SPLITS = (A_WIDTH, A_WIDTH,
          3 * B_WIDTH, B_WIDTH, B_HEADS, B_HEADS,
          C_KEY, C_KEY, C_WIDTH, C_WIDTH, C_RANK)
D_IN = sum(SPLITS)

kernel_name = "hymba_style_sgu_gdn_gla_macaron_deepnorm"


def layer_norm(x, g, b):
    xf = x.astype(jnp.float32)
    mu = jnp.mean(xf, -1, keepdims=True)
    var = jnp.mean(jnp.square(xf - mu), -1, keepdims=True)
    return ((xf - mu) * lax.rsqrt(var + EPS) * g + b).astype(x.dtype)


def rms_norm(x, g):
    xf = x.astype(jnp.float32)
    return (xf * lax.rsqrt(jnp.mean(xf * xf, -1, keepdims=True) + EPS) * g).astype(x.dtype)


def l2_norm(x):
    xf = x.astype(jnp.float32)
    return (xf * lax.rsqrt(jnp.sum(xf * xf, -1, keepdims=True) + 1e-6)).astype(x.dtype)


def swiglu_half(x, w1, w3, w2):
    return 0.5 * ((jax.nn.silu(x @ w1) * (x @ w3)) @ w2)


def to_chunks(x, c):
    b_, t, h, d = x.shape
    return x.reshape(b_, t // c, c, h, d).transpose(0, 3, 1, 2, 4)


def gates_to_chunks(x, c):
    b_, t, h = x.shape
    return x.reshape(b_, t // c, c, h).transpose(0, 3, 1, 2)


def from_chunks(x):
    b_, h, n, c, d = x.shape
    return x.transpose(0, 2, 3, 1, 4).reshape(b_, n * c, h, d)


def causal_short_conv(x, w):
    k = w.shape[0]
    t = x.shape[1]
    xp = jnp.pad(x, ((0, 0), (k - 1, 0), (0, 0)))
    y = w[0] * xp[:, 0:t]
    for i in range(1, k):
        y = y + w[i] * xp[:, i:i + t]
    return y


def spatial_gating(u, v, ln_g, ln_b, w_s, b_s):
    b_, t, _ = v.shape
    n = t // A_CHUNK
    v = layer_norm(v, ln_g, ln_b).reshape(b_, n, A_CHUNK, A_HEADS, HEAD_DIM)
    mask = jnp.tril(jnp.ones((A_CHUNK, A_CHUNK), dtype=bool))
    w = jnp.where(mask, w_s, 0.0)
    z = jnp.einsum('hij,bnjhd->bnihd', w, v) + b_s.T[:, :, None]
    return u * z.reshape(b_, t, A_WIDTH)


def gated_delta_rule(q, k, v, log_g, beta):
    out_dtype = v.dtype
    q, k, v, log_g, beta = (t_.astype(jnp.float32) for t_ in (q, k, v, log_g, beta))
    c = q.shape[3]
    b_, h, _, _, dk = q.shape
    dv = v.shape[-1]
    incl = jnp.tril(jnp.ones((c, c), dtype=bool))
    strict = jnp.tril(jnp.ones((c, c), dtype=bool), -1)
    gam = jnp.cumsum(log_g, axis=-1)
    decay = jnp.exp(jnp.where(incl, gam[..., :, None] - gam[..., None, :], -jnp.inf))
    kk = jnp.einsum('bhnid,bhnjd->bhnij', k, k)
    lower = jnp.where(strict, beta[..., :, None] * kk * decay, 0.0)
    eye = jnp.eye(c, dtype=jnp.float32)
    rhs = jnp.concatenate([beta[..., None] * v, (beta * jnp.exp(gam))[..., None] * k], axis=-1)
    sol = lax.linalg.triangular_solve(eye + lower, rhs, left_side=True, lower=True, unit_diagonal=True)
    u_base, w_state = sol[..., :dv], sol[..., dv:]
    p_intra = jnp.einsum('bhnid,bhnjd->bhnij', q, k) * decay
    q_dec = q * jnp.exp(gam)[..., None]
    k_dec = k * jnp.exp(gam[..., -1:] - gam)[..., None]
    g_tot = jnp.exp(gam[..., -1])

    def step(s, inp):
        u_b, w_c, p_c, qd, kd, gt = inp
        u = u_b - jnp.einsum('bhck,bhkv->bhcv', w_c, s)
        o = jnp.einsum('bhck,bhkv->bhcv', qd, s) + jnp.einsum('bhij,bhjv->bhiv', p_c, u)
        s = gt[..., None, None] * s + jnp.einsum('bhck,bhcv->bhkv', kd, u)
        return s, o

    s0 = jnp.zeros((b_, h, dk, dv), jnp.float32)
    xs = tuple(jnp.moveaxis(t_, 2, 0) for t_ in (u_base, w_state, p_intra, q_dec, k_dec, g_tot))
    _, o = lax.scan(step, s0, xs)
    return jnp.moveaxis(o, 0, 2).astype(out_dtype)


def gated_deltanet(qkv, z, beta_logit, decay_logit, conv_w, a_log, dt_bias, norm_g):
    b_, t, _ = qkv.shape
    qkv = jax.nn.silu(causal_short_conv(qkv, conv_w))
    q, k, v = jnp.split(qkv, 3, axis=-1)
    q = l2_norm(q.reshape(b_, t, B_HEADS, B_DK)) * (B_DK ** -0.5)
    k = l2_norm(k.reshape(b_, t, B_HEADS, B_DK))
    v = v.reshape(b_, t, B_HEADS, B_DV)
    beta = jax.nn.sigmoid(beta_logit.astype(jnp.float32))
    log_g = -jnp.exp(a_log) * jax.nn.softplus(decay_logit.astype(jnp.float32) + dt_bias)
    o = gated_delta_rule(to_chunks(q, B_CHUNK), to_chunks(k, B_CHUNK), to_chunks(v, B_CHUNK),
                         gates_to_chunks(log_g, B_CHUNK), gates_to_chunks(beta, B_CHUNK))
    o = from_chunks(o)
    o = rms_norm(o, norm_g) * jax.nn.silu(z.reshape(b_, t, B_HEADS, B_DV))
    return o.reshape(b_, t, B_WIDTH)


def gla_chunked(q, k, v, log_a):
    out_dtype = v.dtype
    q, k, v, log_a = (t_.astype(jnp.float32) for t_ in (q, k, v, log_a))
    c = q.shape[3]
    b_, h, _, _, dk = q.shape
    dv = v.shape[-1]
    incl = jnp.tril(jnp.ones((c, c), dtype=bool))
    bcum = jnp.cumsum(log_a, axis=3)
    q_dec = q * jnp.exp(bcum)
    p_intra = jnp.where(incl, jnp.einsum('bhnid,bhnjd->bhnij', q_dec, k * jnp.exp(-bcum)), 0.0)
    o_intra = jnp.einsum('bhnij,bhnjv->bhniv', p_intra, v)
    k_dec = k * jnp.exp(bcum[..., -1:, :] - bcum)
    g_tot = jnp.exp(bcum[..., -1, :])

    def step(s, inp):
        o_i, qd, kd, vc, gt = inp
        o = o_i + jnp.einsum('bhck,bhkv->bhcv', qd, s)
        s = gt[..., :, None] * s + jnp.einsum('bhck,bhcv->bhkv', kd, vc)
        return s, o

    s0 = jnp.zeros((b_, h, dk, dv), jnp.float32)
    xs = tuple(jnp.moveaxis(t_, 2, 0) for t_ in (o_intra, q_dec, k_dec, v, g_tot))
    _, o = lax.scan(step, s0, xs)
    return jnp.moveaxis(o, 0, 2).astype(out_dtype)


def gla(q, k, v, r, g_low, gate_up, gate_b, norm_g):
    b_, t, _ = q.shape
    log_a = jax.nn.log_sigmoid((g_low @ gate_up + gate_b).astype(jnp.float32)) / C_TAU
    q = q.reshape(b_, t, C_HEADS, C_DK) * (C_DK ** -0.5)
    k = k.reshape(b_, t, C_HEADS, C_DK)
    v = v.reshape(b_, t, C_HEADS, C_DV)
    log_a = log_a.reshape(b_, t, C_HEADS, C_DK)
    o = gla_chunked(to_chunks(q, C_CHUNK), to_chunks(k, C_CHUNK), to_chunks(v, C_CHUNK),
                    to_chunks(log_a, C_CHUNK))
    o = rms_norm(from_chunks(o), norm_g) * jax.nn.silu(r.reshape(b_, t, C_HEADS, C_DV))
    return o.reshape(b_, t, C_WIDTH)


def setup_inputs(seed: int = 0) -> dict:
    key = jax.random.key(seed)
    ks = jax.random.split(key, 40)
    L = DEPTH
    f32 = jnp.float32

    def nrm(i, shape, scale):
        return jax.random.normal(ks[i], shape, f32) * scale

    def gain(i, shape):
        return 1.0 + 0.1 * jax.random.normal(ks[i], shape, f32)

    a_val = jax.random.uniform(ks[17], (L, B_HEADS), f32, 1.0, 16.0)
    dt = jnp.exp(jax.random.uniform(ks[18], (L, B_HEADS), f32, np.log(1e-3), np.log(1e-1)))
    return {
        "x": jax.random.normal(ks[0], (BATCH, SEQ, D_MODEL), f32),
        "ffn1_w1": nrm(1, (L, D_MODEL, D_FF), D_MODEL ** -0.5),
        "ffn1_w3": nrm(2, (L, D_MODEL, D_FF), D_MODEL ** -0.5),
        "ffn1_w2": nrm(3, (L, D_FF, D_MODEL), BETA_INIT * D_FF ** -0.5),
        "ln1_g": gain(4, (L, D_MODEL)),
        "ln1_b": nrm(5, (L, D_MODEL), 0.02),
        "w_in": nrm(6, (L, D_MODEL, D_IN), D_MODEL ** -0.5),
        "sgu_ln_g": gain(7, (L, A_WIDTH)),
        "sgu_ln_b": nrm(8, (L, A_WIDTH), 0.02),
        "sgu_w": nrm(9, (L, A_HEADS, A_CHUNK, A_CHUNK), 0.5 * A_CHUNK ** -0.5),
        "sgu_b": gain(10, (L, A_HEADS, A_CHUNK)),
        "gdn_conv_w": nrm(11, (L, B_CONV, 3 * B_WIDTH), 0.5),
        "gdn_a_log": jnp.log(a_val),
        "gdn_dt_bias": dt + jnp.log(-jnp.expm1(-dt)),
        "gdn_norm_g": gain(12, (L, B_DV)),
        "gla_gate_up": nrm(13, (L, C_RANK, C_KEY), C_RANK ** -0.5),
        "gla_gate_b": nrm(14, (L, C_KEY), 0.1),
        "gla_norm_g": gain(15, (L, C_DV)),
        "w_out": nrm(16, (L, D_MIX, D_MODEL), BETA_INIT * D_MIX ** -0.5),
        "ln2_g": gain(19, (L, D_MODEL)),
        "ln2_b": nrm(20, (L, D_MODEL), 0.02),
        "ffn2_w1": nrm(21, (L, D_MODEL, D_FF), D_MODEL ** -0.5),
        "ffn2_w3": nrm(22, (L, D_MODEL, D_FF), D_MODEL ** -0.5),
        "ffn2_w2": nrm(23, (L, D_FF, D_MODEL), BETA_INIT * D_FF ** -0.5),
        "ln3_g": gain(24, (L, D_MODEL)),
        "ln3_b": nrm(25, (L, D_MODEL), 0.02),
    }


def reference(x, ffn1_w1, ffn1_w3, ffn1_w2, ln1_g, ln1_b, w_in, sgu_ln_g, sgu_ln_b, sgu_w, sgu_b,
              gdn_conv_w, gdn_a_log, gdn_dt_bias, gdn_norm_g, gla_gate_up, gla_gate_b, gla_norm_g,
              w_out, ln2_g, ln2_b, ffn2_w1, ffn2_w3, ffn2_w2, ln3_g, ln3_b):
    split_at = [int(s) for s in np.cumsum(SPLITS)[:-1]]
    for l in range(DEPTH):
        x = layer_norm(ALPHA * x + swiglu_half(x, ffn1_w1[l], ffn1_w3[l], ffn1_w2[l]), ln1_g[l], ln1_b[l])
        h = x @ w_in[l]
        (a_u, a_v, b_qkv, b_z, b_beta, b_decay,
         c_q, c_k, c_v, c_r, c_g) = jnp.split(h, split_at, axis=-1)
        out_a = spatial_gating(jax.nn.gelu(a_u), jax.nn.gelu(a_v), sgu_ln_g[l], sgu_ln_b[l], sgu_w[l], sgu_b[l])
        out_b = gated_deltanet(b_qkv, b_z, b_beta, b_decay, gdn_conv_w[l], gdn_a_log[l], gdn_dt_bias[l], gdn_norm_g[l])
        out_c = gla(c_q, c_k, c_v, c_r, c_g, gla_gate_up[l], gla_gate_b[l], gla_norm_g[l])
        mix = jnp.concatenate([out_a, out_b, out_c], axis=-1) @ w_out[l]
        x = layer_norm(ALPHA * x + mix, ln2_g[l], ln2_b[l])
        x = layer_norm(ALPHA * x + swiglu_half(x, ffn2_w1[l], ffn2_w3[l], ffn2_w2[l]), ln3_g[l], ln3_b[l])
    return x
```

```cpp
#include <hip/hip_runtime.h>
#define GLA_DBG 0
#include <hip/hip_cooperative_groups.h>
#include <cstdio>
#include <cstdint>
namespace cg = cooperative_groups;
__device__ __forceinline__ int opaque_tid() { int t = threadIdx.x; asm volatile("" : "+v"(t)); return t; }
__device__ __forceinline__ int opaque_bid() { int b = blockIdx.x; asm volatile("" : "+s"(b)); return b; }
namespace pg8 {
#define PG8_LAS __attribute__((address_space(3)))
typedef unsigned short bf16_t;
typedef short bf16x8 __attribute__((ext_vector_type(8)));
typedef float f32x4 __attribute__((ext_vector_type(4)));
typedef unsigned u32x4 __attribute__((ext_vector_type(4)));
constexpr int BM = 256, BK = 64, HALF = 128, HTB = HALF * BK * 2  , STAGE_BYTES = 8 * HTB, NXCD = 8, WGM = 8;

__host__ __device__ __forceinline__ int lds_byte(int r, int c) { const int st = (r >> 4) * 2 + (c >> 5), rr = r & 15, cc = c & 31, ob = rr * 64 + cc * 2; return st * 1024 + (ob ^ (((ob >> 9) & 1) << 5)); }
__host__ __device__ __forceinline__ void stage_rc(int b, int& R, int& C) { const int st = b / 1024, sb = b % 1024, swz = sb ^ (((sb >> 9) & 1) << 5); R = (st >> 1) * 16 + swz / 64; C = (st & 1) * 32 + (swz % 64) / 2; }
__host__ __device__ __forceinline__ int perm32(int rho) { const int n = rho >> 4, i = rho & 15; return 8 * (i >> 2) + 4 * n + (i & 3); }

struct Unit { int pm, pn; };
struct Gemm { const bf16_t* A; const bf16_t* Bt; int M, N, K; };

struct StaticOrder {
    int nM, nN, nwg, G, c;
    __host__ __device__ void init(int M, int N, int G_, int c_) { nM = M / BM; nN = N / BM; nwg = nM * nN; G = G_; c = c_; }
    __host__ __device__ bool next(int i, Unit& u) const {
        const long L = (long)i * G + c; if (L >= nwg) return false;
        int wgid = (int)L; { const int q = nwg / NXCD, r = nwg % NXCD, xcd = wgid % NXCD, off = wgid / NXCD; wgid = (xcd < r ? xcd * (q + 1) : r * (q + 1) + (xcd - r) * q) + off; }
        const int nig = WGM * nN, gid = wgid / nig, fm = gid * WGM, gsz = (nM - fm) < WGM ? (nM - fm) : WGM;
        u.pm = fm + ((wgid % nig) % gsz); u.pn = (wgid % nig) / gsz; return true;
    }
    __device__ __forceinline__ void a_ready(const Unit&) const {}
    __device__ __forceinline__ void done(const Unit&) const {}
};

__device__ __forceinline__ unsigned cvt_pk_bf16(float lo, float hi) { unsigned r; asm volatile("v_cvt_pk_bf16_f32 %0, %1, %2" : "=v"(r) : "v"(lo), "v"(hi)); return r; }
typedef float f32x2 __attribute__((ext_vector_type(2)));
__device__ __forceinline__ f32x2 gelu_pk(f32x2 v) {
    const f32x2 av = __builtin_elementwise_abs(v), d = av * 0.2316418882f + 1.0f;
    f32x2 t; t.x = __builtin_amdgcn_rcpf(d.x); t.y = __builtin_amdgcn_rcpf(d.y);
    f32x2 q = t * 0.5307027145f + (-0.7265760135f); q = q * t + 0.7107068705f; q = q * t + (-0.142248368f); q = q * t + 0.127414796f; q = q * t;
    const f32x2 s = (v * v) * (-0.72134752044f);
    f32x2 e; e.x = __builtin_amdgcn_exp2f(s.x); e.y = __builtin_amdgcn_exp2f(s.y);
    const f32x2 m = v * (q * e), r = v - m;
    f32x2 o; o.x = v.x < 0.f ? m.x : r.x; o.y = v.y < 0.f ? m.y : r.y; return o;
}

template <int ACT  > struct EpiBf16 {
    static constexpr bool PERM = true, AFTER_DRAIN = false; static_assert(ACT == 0 || ACT == 1, "EpiBf16: ACT is 0 (none) or 1 (gelu_pk)");
    bf16_t* O; int ldc; const float* bias; int split_cols; size_t split_stride; float scale0;
    __device__ __forceinline__ void operator()(const f32x4 (&acc)[2][2][4][2], const Unit& u, int wr, int wc, int fr, int fq) const {
        const int row0 = u.pm * BM + wr * 64 + fr; int colt = u.pn * BM; bf16_t* base = O;
        float sc = 1.f; if (split_cols) { const int t = colt / split_cols; base += (size_t)t * split_stride; colt -= t * split_cols; if (t == 0) sc = scale0; }
        const int col0 = colt + wc * 32 + 8 * fq, bcol0 = u.pn * BM + wc * 32 + 8 * fq;
        f32x4 bv[2][2];
#pragma unroll
        for (int bj = 0; bj < 2; ++bj)
#pragma unroll
            for (int n = 0; n < 2; ++n) bv[bj][n] = bias ? *(const f32x4*)(bias + bcol0 + bj * HALF + 4 * n) : (f32x4){0.f, 0.f, 0.f, 0.f};
#pragma unroll
        for (int ai = 0; ai < 2; ++ai)
#pragma unroll
            for (int m = 0; m < 4; ++m) { bf16_t* rowp = base + (size_t)(row0 + ai * HALF + m * 16) * ldc + col0;
#pragma unroll
                for (int bj = 0; bj < 2; ++bj) { f32x4 v0 = acc[ai][bj][m][0] + bv[bj][0], v1 = acc[ai][bj][m][1] + bv[bj][1];
                    if (ACT == 1) { f32x2 a = gelu_pk((f32x2){v0[0], v0[1]}), b = gelu_pk((f32x2){v0[2], v0[3]}), c = gelu_pk((f32x2){v1[0], v1[1]}), d = gelu_pk((f32x2){v1[2], v1[3]});
                        v0 = (f32x4){a.x, a.y, b.x, b.y}; v1 = (f32x4){c.x, c.y, d.x, d.y}; }
                    v0 = v0 * sc; v1 = v1 * sc; u32x4 w; w.x = cvt_pk_bf16(v0[0], v0[1]); w.y = cvt_pk_bf16(v0[2], v0[3]); w.z = cvt_pk_bf16(v1[0], v1[1]); w.w = cvt_pk_bf16(v1[2], v1[3]);
                    *(u32x4*)(rowp + bj * HALF) = w; } }
    }
};
__device__ __forceinline__ float fast_sigmoid(float x) { return __builtin_amdgcn_rcpf(1.0f + __expf(-x)); }
struct EpiSwiglu {
    static constexpr bool PERM = true, AFTER_DRAIN = false;
    bf16_t* O; int ldc;
    __device__ __forceinline__ void operator()(const f32x4 (&acc)[2][2][4][2], const Unit& u, int wr, int wc, int fr, int fq) const {
        const int row0 = u.pm * BM + wr * 64 + fr; const int col0 = u.pn * HALF + wc * 32 + 8 * fq;
#pragma unroll
        for (int ai = 0; ai < 2; ++ai)
#pragma unroll
            for (int m = 0; m < 4; ++m) { bf16_t* rowp = O + (size_t)(row0 + ai * HALF + m * 16) * ldc + col0;
                float h[8];
#pragma unroll
                for (int n = 0; n < 2; ++n)
#pragma unroll
                    for (int i = 0; i < 4; ++i) { const float g = acc[ai][0][m][n][i], up = acc[ai][1][m][n][i]; h[n * 4 + i] = g * fast_sigmoid(g) * up; }
                u32x4 w; w.x = cvt_pk_bf16(h[0], h[1]); w.y = cvt_pk_bf16(h[2], h[3]); w.z = cvt_pk_bf16(h[4], h[5]); w.w = cvt_pk_bf16(h[6], h[7]);
                *(u32x4*)rowp = w; }
    }
};
struct EpiProj {
    static constexpr bool PERM = true, AFTER_DRAIN = false;
    bf16_t* O; int ldc; int gelu_tiles;
    __device__ __forceinline__ void operator()(const f32x4 (&acc)[2][2][4][2], const Unit& u, int wr, int wc, int fr, int fq) const {
        const int row0 = u.pm * BM + wr * 64 + fr; const int col0 = u.pn * BM + wc * 32 + 8 * fq; const bool act = u.pn < gelu_tiles;
#pragma unroll
        for (int ai = 0; ai < 2; ++ai)
#pragma unroll
            for (int m = 0; m < 4; ++m) { bf16_t* rowp = O + (size_t)(row0 + ai * HALF + m * 16) * ldc + col0;
#pragma unroll
                for (int bj = 0; bj < 2; ++bj) { float h[8];
#pragma unroll
                    for (int n = 0; n < 2; ++n)
#pragma unroll
                        for (int i = 0; i < 4; ++i) { float v = acc[ai][bj][m][n][i];
                            if (act) { const float t = 1.5957691216f * (v + 0.044715f * v * v * v); v = v * fast_sigmoid(t); }
                            h[n * 4 + i] = v; }
                    u32x4 w; w.x = cvt_pk_bf16(h[0], h[1]); w.y = cvt_pk_bf16(h[2], h[3]); w.z = cvt_pk_bf16(h[4], h[5]); w.w = cvt_pk_bf16(h[6], h[7]);
                    *(u32x4*)(rowp + bj * HALF) = w; } }
    }
};
struct EpiRes {
    static constexpr bool PERM = false, AFTER_DRAIN = false;
    float* X; int ldc; float alpha, cs;
    __device__ __forceinline__ void operator()(const f32x4 (&acc)[2][2][4][2], const Unit& u, int wr, int wc, int fr, int fq) const {
        const int col0 = u.pn * BM + wc * 32 + 4 * fq;
#pragma unroll
        for (int ai = 0; ai < 2; ++ai)
#pragma unroll
            for (int m = 0; m < 4; ++m) { float* rowp = X + (size_t)(u.pm * BM + ai * HALF + wr * 64 + m * 16 + fr) * ldc + col0;
#pragma unroll
                for (int bj = 0; bj < 2; ++bj)
#pragma unroll
                    for (int n = 0; n < 2; ++n) { f32x4* p = (f32x4*)(rowp + bj * HALF + n * 16); const f32x4 b = *p; f32x4 o = b * alpha + acc[ai][bj][m][n] * cs;
#ifdef DBG_NANFILTER
                        for (int e = 0; e < 4; ++e) if (!(fabsf(o[e]) < 1e30f)) o[e] = 12345.0f;
#endif
                        *p = o; } }
    }
};
template <class Epi, class Sched, bool ALIGN_EPI = false, bool SP2 = false>
__device__ __forceinline__ void gemm_phase(PG8_LAS unsigned char* lds, const Gemm g, const Sched& S, const Epi& E) {
    const int tid = opaque_tid(), wid = __builtin_amdgcn_readfirstlane(tid >> 6), lane = tid & 63, wr = wid >> 2, wc = wid & 3, fr = lane & 15, fq = lane >> 4;
    const int K = g.K, nt = K / BK;
    unsigned voffA[2], voffB[2];
#pragma unroll
    for (int i = 0; i < 2; ++i) { int R, C; stage_rc(tid * 16 + i * 8192, R, C); const int Rb = Epi::PERM ? ((R & ~31) + perm32(R & 31)) : R;
        voffA[i] = (unsigned)(R * K + C) * 2u; voffB[i] = (unsigned)(Rb * K + C) * 2u; }
    const size_t kstep = (size_t)(BK * 2);
    const size_t hstep = (size_t)HALF * K * 2;
    const size_t tstep = 2 * hstep;
    const unsigned ldsw = (unsigned)wid * 1024u;
    const int aoff = lds_byte(wr * 64 + fr, fq * 8), boff = lds_byte(wc * 32 + fr, fq * 8);
#define PG8_SA(b, h) (((b) * 2 + (h)) * HTB)
#define PG8_SB(b, h) ((4 + (b) * 2 + (h)) * HTB)
#define PG8_STAGE(bufoff, gbase, voff) do { _Pragma("unroll") for (int _i = 0; _i < 2; ++_i) \
        __builtin_amdgcn_global_load_lds((const unsigned*)((const char*)(gbase) + (voff)[_i]), (PG8_LAS unsigned*)(lds + (bufoff) + ldsw + _i * 8192), 16, 0, 0); } while (0)
#define PG8_LDA(dst, b, h) do { _Pragma("unroll") for (int m = 0; m < 4; ++m) _Pragma("unroll") for (int k = 0; k < 2; ++k) dst[m][k] = *(const PG8_LAS bf16x8*)(lds + PG8_SA(b, h) + aoff + m * 2048 + k * 1024); } while (0)
#define PG8_LDB(dst, b, h) do { _Pragma("unroll") for (int n = 0; n < 2; ++n) _Pragma("unroll") for (int k = 0; k < 2; ++k) dst[n][k] = *(const PG8_LAS bf16x8*)(lds + PG8_SB(b, h) + boff + n * 2048 + k * 1024); } while (0)
#define PG8_MMA(ai, bj, At, Bt) do { __builtin_amdgcn_s_setprio(1); _Pragma("unroll") for (int m = 0; m < 4; ++m) _Pragma("unroll") for (int n = 0; n < 2; ++n) _Pragma("unroll") for (int k = 0; k < 2; ++k) \
        acc[ai][bj][m][n] = __builtin_amdgcn_mfma_f32_16x16x32_bf16(Bt[n][k], At[m][k], acc[ai][bj][m][n], 0, 0, 0); __builtin_amdgcn_s_setprio(0); } while (0)
#define PG8_WAIT_V(n) asm volatile("s_waitcnt vmcnt(" #n ")" ::: "memory")
#define PG8_WAIT_L(n) asm volatile("s_waitcnt lgkmcnt(" #n ")" ::: "memory")
#define PG8_BAR __builtin_amdgcn_s_barrier()
#define PG8_SCHED __builtin_amdgcn_sched_barrier(0)
    Unit cur, nxt; int ui = 0;
    if (!S.next(0, cur)) return;
    f32x4 acc[2][2][4][2];
#pragma unroll
    for (int a = 0; a < 2; ++a)
#pragma unroll
        for (int b = 0; b < 2; ++b)
#pragma unroll
            for (int m = 0; m < 4; ++m)
#pragma unroll
                for (int n = 0; n < 2; ++n) acc[a][b][m][n] = (f32x4){0.f, 0.f, 0.f, 0.f};
    bf16x8 At[4][2], B0[2][2], B1[2][2];
    const char* cA = (const char*)g.A + (size_t)cur.pm * tstep; const char* cB = (const char*)g.Bt + (size_t)cur.pn * tstep;
    S.a_ready(cur);
    if constexpr (SP2) {
        PG8_STAGE(PG8_SB(0, 0), cB, voffB); PG8_STAGE(PG8_SB(0, 1), cB + hstep, voffB); PG8_STAGE(PG8_SA(0, 0), cA, voffA); PG8_STAGE(PG8_SA(0, 1), cA + hstep, voffA);
        if (wr == 1) PG8_BAR;
        PG8_WAIT_V(2); PG8_BAR;
        PG8_STAGE(PG8_SB(1, 0), cB + kstep, voffB); PG8_STAGE(PG8_SA(1, 0), cA + kstep, voffA); PG8_STAGE(PG8_SB(1, 1), cB + hstep + kstep, voffB);
        PG8_WAIT_V(6); PG8_BAR;
    } else {
        PG8_STAGE(PG8_SB(0, 0), cB, voffB); PG8_STAGE(PG8_SA(0, 0), cA, voffA); PG8_STAGE(PG8_SB(0, 1), cB + hstep, voffB); PG8_STAGE(PG8_SA(0, 1), cA + hstep, voffA);
        if (wr == 1) PG8_BAR;
        PG8_WAIT_V(4); PG8_BAR;
        PG8_STAGE(PG8_SB(1, 0), cB + kstep, voffB); PG8_STAGE(PG8_SA(1, 0), cA + kstep, voffA); PG8_STAGE(PG8_SB(1, 1), cB + hstep + kstep, voffB);
        PG8_WAIT_V(6); PG8_BAR;
    }
    for (;;) {
        const bool has_next = S.next(ui + 1, nxt);
        const char* nA = has_next ? (const char*)g.A + (size_t)nxt.pm * tstep : cA; const char* nB = has_next ? (const char*)g.Bt + (size_t)nxt.pn * tstep : cB;
        for (int t = 0; t < nt; t += 2) {
            const bool last = (t == nt - 2);
            const char* a1 = cA + (size_t)(t + 1) * kstep;
            const char* a2 = last ? nA : cA + (size_t)(t + 2) * kstep; const char* b2 = last ? nB : cB + (size_t)(t + 2) * kstep;
            const char* a3 = a2 + kstep; const char* b3 = b2 + kstep;
            if (last && has_next) S.a_ready(nxt);
            if constexpr (SP2) {
            PG8_LDB(B0, 0, 0); PG8_LDB(B1, 0, 1); PG8_SCHED; PG8_LDA(At, 0, 0); PG8_STAGE(PG8_SA(1, 1), a1 + hstep, voffA);
            PG8_WAIT_V(8); PG8_WAIT_L(0); PG8_BAR; PG8_MMA(0, 0, At, B0); PG8_MMA(0, 1, At, B1); PG8_BAR; PG8_SCHED;
            PG8_LDA(At, 0, 1); PG8_STAGE(PG8_SB(0, 0), b2, voffB); PG8_STAGE(PG8_SB(0, 1), b2 + hstep, voffB); PG8_STAGE(PG8_SA(0, 0), a2, voffA);
            PG8_WAIT_V(8); PG8_WAIT_L(0); PG8_BAR; PG8_MMA(1, 0, At, B0); PG8_MMA(1, 1, At, B1); PG8_BAR; PG8_SCHED;
            PG8_LDB(B0, 1, 0); PG8_LDB(B1, 1, 1); PG8_SCHED; PG8_LDA(At, 1, 0); PG8_STAGE(PG8_SA(0, 1), a2 + hstep, voffA);
            PG8_WAIT_V(8); PG8_WAIT_L(0); PG8_BAR; PG8_MMA(0, 0, At, B0); PG8_MMA(0, 1, At, B1); PG8_BAR; PG8_SCHED;
            PG8_LDA(At, 1, 1); PG8_STAGE(PG8_SB(1, 0), b3, voffB); PG8_STAGE(PG8_SB(1, 1), b3 + hstep, voffB); PG8_STAGE(PG8_SA(1, 0), a3, voffA);
            PG8_WAIT_V(8); PG8_WAIT_L(0); PG8_BAR; PG8_MMA(1, 0, At, B0); PG8_MMA(1, 1, At, B1); PG8_BAR; PG8_SCHED;
            } else {
            PG8_LDB(B0, 0, 0); PG8_SCHED; PG8_LDA(At, 0, 0); PG8_STAGE(PG8_SA(1, 1), a1 + hstep, voffA);
            PG8_WAIT_L(8); PG8_BAR; PG8_WAIT_L(0); PG8_MMA(0, 0, At, B0); PG8_BAR; PG8_SCHED;
            PG8_LDB(B1, 0, 1); PG8_STAGE(PG8_SB(0, 0), b2, voffB);
            PG8_BAR; PG8_WAIT_L(0); PG8_MMA(0, 1, At, B1); PG8_BAR;
            PG8_LDA(At, 0, 1); PG8_STAGE(PG8_SA(0, 0), a2, voffA);
            PG8_BAR; PG8_WAIT_L(0); PG8_MMA(1, 0, At, B0); PG8_BAR; PG8_SCHED;
            PG8_STAGE(PG8_SB(0, 1), b2 + hstep, voffB);
            PG8_WAIT_V(6); PG8_BAR; PG8_MMA(1, 1, At, B1); PG8_BAR;
            PG8_LDB(B0, 1, 0); PG8_SCHED; PG8_LDA(At, 1, 0); PG8_STAGE(PG8_SA(0, 1), a2 + hstep, voffA);
            PG8_WAIT_L(8); PG8_BAR; PG8_WAIT_L(0); PG8_MMA(0, 0, At, B0); PG8_BAR; PG8_SCHED;
            PG8_LDB(B1, 1, 1); PG8_STAGE(PG8_SB(1, 0), b3, voffB);
            PG8_BAR; PG8_WAIT_L(0); PG8_MMA(0, 1, At, B1); PG8_BAR;
            PG8_LDA(At, 1, 1); PG8_STAGE(PG8_SA(1, 0), a3, voffA);
            PG8_BAR; PG8_WAIT_L(0); PG8_MMA(1, 0, At, B0); PG8_BAR; PG8_SCHED;
            PG8_STAGE(PG8_SB(1, 1), b3 + hstep, voffB);
            PG8_WAIT_V(6); PG8_BAR; PG8_MMA(1, 1, At, B1); PG8_BAR;
            }
        }
        if constexpr (ALIGN_EPI) { if (wr == 0) PG8_BAR; }
        if constexpr (!Epi::AFTER_DRAIN) { E(acc, cur, wr, wc, fr, fq); S.done(cur); }
        if (!has_next) break;
#pragma unroll
        for (int a = 0; a < 2; ++a)
#pragma unroll
            for (int b = 0; b < 2; ++b)
#pragma unroll
                for (int m = 0; m < 4; ++m)
#pragma unroll
                    for (int n = 0; n < 2; ++n) acc[a][b][m][n] = (f32x4){0.f, 0.f, 0.f, 0.f};
        cur = nxt; cA = nA; cB = nB; ++ui;
        if constexpr (ALIGN_EPI) { if (wr == 1) PG8_BAR; }
    }
    PG8_WAIT_V(0);
    if constexpr (!ALIGN_EPI) { if (wr == 0) PG8_BAR; }
    PG8_BAR;
    if constexpr (Epi::AFTER_DRAIN) { E.fused(acc, cur, wr, wc, fr, fq, lds, wid, lane); S.done(cur); }
#undef PG8_SA
#undef PG8_SB
#undef PG8_STAGE
#undef PG8_LDA
#undef PG8_LDB
#undef PG8_MMA
#undef PG8_WAIT_V
#undef PG8_WAIT_L
#undef PG8_BAR
#undef PG8_SCHED
}
}
typedef unsigned short bf16;
typedef short bf16x8 __attribute__((ext_vector_type(8)));
typedef float f32x4 __attribute__((ext_vector_type(4)));
typedef unsigned u32x4 __attribute__((ext_vector_type(4)));
typedef unsigned u32x2 __attribute__((ext_vector_type(2)));
#define LAS __attribute__((address_space(3)))
constexpr int M = 16384, D = 1024, FF = 2816, DIN = 3360, DINP = 3584, SEQ = 8192, NLAYER = 4, NPH = 13;
constexpr float ALPHA = 1.681792830507429f, EPS = 1e-5f;
constexpr int C_AU = 0, C_AV = 256, C_BQ = 512, C_BZ = 2048, C_BBETA = 2560, C_BDEC = 2568, C_CQ = 2576, C_CK = 2704, C_CV = 2832, C_CR = 3088, C_CG = 3344;
constexpr size_t MiB = 1u << 20;
constexpr size_t WS_CTL = 0, WS_W = 1 * MiB, WS_XB = 44 * MiB, WS_HP = 76 * MiB, WS_MIX = 188 * MiB;
constexpr size_t OW13A = 0, OW2A = 11534336, OWIN = 17301504, OWOUT = 24641536, OW13B = 26738688, OW2B = 38273024, OWM = 42 * MiB;
constexpr size_t WS_UBT = 220 * MiB, WS_WN = 236 * MiB, WS_KDT = 252 * MiB, WS_PF = 268 * MiB, WS_QD = 284 * MiB, WS_SP = 300 * MiB, WS_UF = 316 * MiB, WS_GTOT = 332 * MiB;
constexpr size_t WS_OIT = 333 * MiB, WS_QDG = 349 * MiB, WS_BNT = 353 * MiB, WS_ST = 361 * MiB, WS_GT = 365 * MiB, WS_END = 366 * MiB;
constexpr int LDS_BYTES = 133120;
#ifndef PH_HI
#define PH_HI (NLAYER * NPH)
#endif
#ifndef MIXSEL
#define MIXSEL 7
#endif
#ifndef ONE_LAUNCH
#define ONE_LAUNCH 1
#endif

__device__ __forceinline__ float bf2f(bf16 b) { return __uint_as_float((unsigned)b << 16); }
__device__ __forceinline__ float bflo(unsigned u) { return __uint_as_float(u << 16); }
__device__ __forceinline__ float bfhi(unsigned u) { return __uint_as_float(u & 0xffff0000u); }
typedef float f32x2_t __attribute__((ext_vector_type(2))); typedef __bf16 bf16x2_t __attribute__((ext_vector_type(2)));
__device__ __forceinline__ unsigned pk2(float lo, float hi) { f32x2_t v = {lo, hi}; bf16x2_t b = __builtin_convertvector(v, bf16x2_t); return __builtin_bit_cast(unsigned, b); }
__device__ __forceinline__ bf16 f2bf(float f) { return (bf16)(pk2(f, 0.f) & 0xffffu); }
__device__ __forceinline__ float sigm(float x) { return 1.0f / (1.0f + __expf(-x)); }
__device__ __forceinline__ float softplusf(float x) { return fmaxf(x, 0.f) + log1pf(__expf(-fabsf(x))); }
__device__ __forceinline__ bf16x8 mk8(u32x2 a, u32x2 b) { u32x4 v = {a.x, a.y, b.x, b.y}; return __builtin_bit_cast(bf16x8, v); }
__device__ __forceinline__ bf16x8 as8(u32x4 v) { return __builtin_bit_cast(bf16x8, v); }
__device__ __forceinline__ f32x4 mfma16(bf16x8 a, bf16x8 b, f32x4 c) { return __builtin_amdgcn_mfma_f32_16x16x32_bf16(a, b, c, 0, 0, 0); }
__device__ __forceinline__ float wave_sum(float v) {
#pragma unroll
    for (int o = 1; o < 64; o <<= 1) v += __shfl_xor(v, o);
    return v;
}

struct KArgs { const float* in[26]; float* out; unsigned char* ws; int lo, hi; };

__device__ __forceinline__ void tr_item(const float* W, int K, int N, bf16* WT, int mode, float* scr, int item, int lane) {
    const int nblk = N / 32, kb = item / nblk, nb = item - kb * nblk, k0 = 64 * kb, n0 = 32 * nb;
    const int drow = (mode == 0) ? n0 : ((n0 >> 7) * 256 + (n0 & 127) + (mode == 2 ? 128 : 0));
#pragma unroll 8
    for (int i = 0; i < 32; ++i) { const int kk = 2 * i + (lane >> 5); scr[kk * 33 + (lane & 31)] = W[(size_t)(k0 + kk) * N + n0 + (lane & 31)]; }
    asm volatile("s_waitcnt lgkmcnt(0)" ::: "memory");
    const int c = lane & 7;
#pragma unroll
    for (int j = 0; j < 4; ++j) { const int n = (lane >> 3) + 8 * j; const float* s = scr + (8 * c) * 33 + n;
        u32x4 o; o.x = pk2(s[0 * 33], s[1 * 33]); o.y = pk2(s[2 * 33], s[3 * 33]); o.z = pk2(s[4 * 33], s[5 * 33]); o.w = pk2(s[6 * 33], s[7 * 33]);
        *(u32x4*)(WT + (size_t)(drow + n) * K + k0 + 8 * c) = o; }
    asm volatile("s_waitcnt lgkmcnt(0)" ::: "memory");
}

__device__ __forceinline__ void phase_conv(const KArgs& a, int l, unsigned char* lds) {
    const int tid = opaque_tid(), lane = tid & 63, wave = tid >> 6;
    float* scr = (float*)(lds + wave * 8704);
    unsigned char* wb = a.ws + WS_W;
    const int gw = opaque_bid() * 8 + wave, NGW = gridDim.x * 8;
    constexpr int I_FF = 1408, I_IN = 1680, I_OUT = 512, NITEMS = 6 * I_FF + I_IN + I_OUT;
    for (int it = gw; it < NITEMS; it += NGW) {
        int r = it;
        if (r < I_FF) { tr_item(a.in[1] + (size_t)l * D * FF, D, FF, (bf16*)(wb + OW13A), 1, scr, r, lane); continue; } r -= I_FF;
        if (r < I_FF) { tr_item(a.in[2] + (size_t)l * D * FF, D, FF, (bf16*)(wb + OW13A), 2, scr, r, lane); continue; } r -= I_FF;
        if (r < I_FF) { tr_item(a.in[3] + (size_t)l * D * FF, FF, D, (bf16*)(wb + OW2A), 0, scr, r, lane); continue; } r -= I_FF;
        if (r < I_IN) { tr_item(a.in[6] + (size_t)l * D * DIN, D, DIN, (bf16*)(wb + OWIN), 0, scr, r, lane); continue; } r -= I_IN;
        if (r < I_OUT) { tr_item(a.in[18] + (size_t)l * D * D, D, D, (bf16*)(wb + OWOUT), 0, scr, r, lane); continue; } r -= I_OUT;
        if (r < I_FF) { tr_item(a.in[21] + (size_t)l * D * FF, D, FF, (bf16*)(wb + OW13B), 1, scr, r, lane); continue; } r -= I_FF;
        if (r < I_FF) { tr_item(a.in[22] + (size_t)l * D * FF, D, FF, (bf16*)(wb + OW13B), 2, scr, r, lane); continue; } r -= I_FF;
        tr_item(a.in[23] + (size_t)l * D * FF, FF, D, (bf16*)(wb + OW2B), 0, scr, r, lane);
    }
    const int gt = opaque_bid() * 512 + tid, NGT = gridDim.x * 512;
    { u32x4* p = (u32x4*)(wb + OWIN + (size_t)DIN * D * 2); const int n16 = (DINP - DIN) * D * 2 / 16;
      for (int i = gt; i < n16; i += NGT) p[i] = (u32x4){0u, 0u, 0u, 0u}; }
    { const float* sw = a.in[9] + (size_t)l * 65536; bf16* wm = (bf16*)(wb + OWM);
      for (int i = gt; i < 65536; i += NGT) { const int ii = (i >> 7) & 127, jj = i & 127; wm[i] = (jj <= ii) ? f2bf(sw[i]) : (bf16)0; } }
    if (l == 0) {
        const f32x4* xs = (const f32x4*)a.in[0]; f32x4* xo = (f32x4*)a.out; u32x2* xb = (u32x2*)(a.ws + WS_XB);
        for (int i = gt; i < M * D / 4; i += NGT) { const f32x4 v = xs[i]; xo[i] = v; xb[i] = (u32x2){pk2(v.x, v.y), pk2(v.z, v.w)}; }
    }
}

__device__ __forceinline__ void phase_ln(const KArgs& a, const float* g, const float* b) {
    const int tid = opaque_tid(), lane = tid & 63, wave = tid >> 6;
    const int gw = opaque_bid() * 8 + wave, NGW = gridDim.x * 8;
    f32x4 gv[4], bv[4];
#pragma unroll
    for (int j = 0; j < 4; ++j) { gv[j] = ((const f32x4*)g)[64 * j + lane]; bv[j] = ((const f32x4*)b)[64 * j + lane]; }
    for (int m = gw; m < M; m += NGW) {
        f32x4* xr = (f32x4*)(a.out + (size_t)m * D) + lane; u32x2* xb = (u32x2*)(a.ws + WS_XB + (size_t)m * D * 2) + lane;
        f32x4 v[4]; float s = 0.f;
#pragma unroll
        for (int j = 0; j < 4; ++j) { v[j] = xr[64 * j]; s += (v[j].x + v[j].y) + (v[j].z + v[j].w); }
        const float mean = wave_sum(s) * (1.f / D); float s2 = 0.f;
#pragma unroll
        for (int j = 0; j < 4; ++j) { v[j] = v[j] - mean; s2 += (v[j].x * v[j].x + v[j].y * v[j].y) + (v[j].z * v[j].z + v[j].w * v[j].w); }
        const float rstd = 1.f / sqrtf(wave_sum(s2) * (1.f / D) + EPS);
#pragma unroll
        for (int j = 0; j < 4; ++j) { const f32x4 y = v[j] * rstd * gv[j] + bv[j]; xr[64 * j] = y; xb[64 * j] = (u32x2){pk2(y.x, y.y), pk2(y.z, y.w)}; }
    }
}
__device__ __forceinline__ void m1_gdn(const KArgs& a, int l, int item, unsigned char* lds) {
    const int tid = opaque_tid(), lane = tid & 63, wave = tid >> 6, slot = wave >> 2, sw = wave & 3, tid4 = tid & 255;
    const int r = lane & 15, q = lane >> 4;
    const int unit = item * 2 + slot, b = unit >> 10, h = (unit >> 7) & 7, n = unit & 127;
    const int row0 = b * SEQ + n * 64;
    unsigned char* sl = lds + slot * 45056;
    bf16* qbf = (bf16*)sl; bf16* kbf = (bf16*)(sl + 9216); bf16* vbf = (bf16*)(sl + 18432);
    float* Lf = (float*)(sl + 27648); bf16* Wl = (bf16*)(sl + 27648);
    float* betaL = (float*)(sl + 44032); float* gamL = (float*)(sl + 44288);
    const bf16* HP = (const bf16*)(a.ws + WS_HP);
    const float* cw = a.in[11] + (size_t)l * 4 * 1536;
#pragma unroll 1
    for (int it = 0; it < 6; ++it) {
        const int e = it * 256 + tid4, tok = e / 24, g = e - tok * 24, ten = g >> 3, sub = g & 7;
        const int chh = ten * 512 + h * 64 + sub * 8;
        float y[8];
#pragma unroll
        for (int i = 0; i < 8; ++i) y[i] = 0.f;
#pragma unroll
        for (int tap = 0; tap < 4; ++tap) {
            const int tt = tok - 3 + tap;
            if (n * 64 + tt >= 0) {
                const u32x4 xv = *(const u32x4*)(HP + (size_t)(row0 + tt) * DINP + C_BQ + chh);
                const f32x4 w0 = *(const f32x4*)(cw + tap * 1536 + chh), w1 = *(const f32x4*)(cw + tap * 1536 + chh + 4);
                y[0] += w0.x * bflo(xv.x); y[1] += w0.y * bfhi(xv.x); y[2] += w0.z * bflo(xv.y); y[3] += w0.w * bfhi(xv.y);
                y[4] += w1.x * bflo(xv.z); y[5] += w1.y * bfhi(xv.z); y[6] += w1.z * bflo(xv.w); y[7] += w1.w * bfhi(xv.w);
            }
        }
        float ss = 0.f;
#pragma unroll
        for (int i = 0; i < 8; ++i) { y[i] = y[i] * sigm(y[i]); ss += y[i] * y[i]; }
        ss += __shfl_xor(ss, 1); ss += __shfl_xor(ss, 2); ss += __shfl_xor(ss, 4);
        const float inv = (ten == 2) ? 1.f : (rsqrtf(ss + 1e-6f) * (ten == 0 ? 0.125f : 1.f));
        u32x4 o; o.x = pk2(y[0] * inv, y[1] * inv); o.y = pk2(y[2] * inv, y[3] * inv); o.z = pk2(y[4] * inv, y[5] * inv); o.w = pk2(y[6] * inv, y[7] * inv);
        bf16* dst = (ten == 0 ? qbf : (ten == 1 ? kbf : vbf)) + tok * 72 + sub * 8;
        *(u32x4*)dst = o;
    }
    if (tid4 < 64) {
        const int tok = tid4;
        const float bl = bf2f(HP[(size_t)(row0 + tok) * DINP + C_BBETA + h]), dl = bf2f(HP[(size_t)(row0 + tok) * DINP + C_BDEC + h]);
        const float beta = sigm(bl);
        float lg = -expf(a.in[12][l * 8 + h]) * softplusf(dl + a.in[13][l * 8 + h]);
#pragma unroll
        for (int off = 1; off < 64; off <<= 1) { const float t = __shfl_up(lg, off); if (lane >= off) lg += t; }
        betaL[tok] = beta; gamL[tok] = lg;
    }
    __syncthreads();
    {
        const int it_ = sw;
        bf16x8 ka[2], qb[2];
#pragma unroll
        for (int ks = 0; ks < 2; ++ks) { ka[ks] = *(const bf16x8*)(kbf + (16 * it_ + r) * 72 + 32 * ks + 8 * q); qb[ks] = *(const bf16x8*)(qbf + (16 * it_ + r) * 72 + 32 * ks + 8 * q); }
        u32x2 pp[4];
#pragma unroll
        for (int jt = 0; jt < 4; ++jt) {
            pp[jt] = (u32x2){0u, 0u};
            if (jt <= it_) {
                bf16x8 kb[2];
#pragma unroll
                for (int ks = 0; ks < 2; ++ks) kb[ks] = *(const bf16x8*)(kbf + (16 * jt + r) * 72 + 32 * ks + 8 * q);
                f32x4 acc = {0.f, 0.f, 0.f, 0.f};
                acc = mfma16(ka[0], kb[0], acc); acc = mfma16(ka[1], kb[1], acc);
                { const int j = 16 * jt + r; const float gj = gamL[j];
#pragma unroll
                  for (int ii = 0; ii < 4; ++ii) { const int i = 16 * it_ + 4 * q + ii; Lf[i * 64 + j] = (j < i) ? betaL[i] * acc[ii] * __expf(gamL[i] - gj) : 0.f; } }
                f32x4 pc = {0.f, 0.f, 0.f, 0.f};
                pc = mfma16(kb[0], qb[0], pc); pc = mfma16(kb[1], qb[1], pc);
                { const int i = 16 * it_ + r; const float gi = gamL[i]; float pv[4];
#pragma unroll
                  for (int jj = 0; jj < 4; ++jj) { const int j = 16 * jt + 4 * q + jj; pv[jj] = (j <= i) ? pc[jj] * __expf(gi - gamL[j]) : 0.f; }
                  pp[jt] = (u32x2){pk2(pv[0], pv[1]), pk2(pv[2], pv[3])}; }
            }
        }
        u32x4* Pf = (u32x4*)(a.ws + WS_PF) + ((size_t)(unit * 4 + it_) * 2) * 64 + lane;
        Pf[0] = (u32x4){pp[0].x, pp[0].y, pp[1].x, pp[1].y};
        Pf[64] = (u32x4){pp[2].x, pp[2].y, pp[3].x, pp[3].y};
    }
    __syncthreads();
    float x[64];
    if (tid4 < 128) {
        const bool isk = tid4 >= 64; const int cc = tid4 & 63;
        const bf16* src = isk ? kbf : vbf;
#pragma unroll
        for (int i = 0; i < 64; ++i) {
            const float bi = betaL[i];
            float s = bf2f(src[i * 72 + cc]) * (isk ? bi * __expf(gamL[i]) : bi);
#pragma unroll
            for (int jj = 0; jj < (i + 3) / 4; ++jj) {
                const f32x4 Lr = *(const f32x4*)(Lf + i * 64 + 4 * jj);
#pragma unroll
                for (int e = 0; e < 4; ++e) if (4 * jj + e < i) s -= Lr[e] * x[4 * jj + e];
            }
            x[i] = s;
            asm volatile("" : "+v"(x[i]) :: "memory");
        }
    } else {
        const int t2 = tid4 - 128; const float glast = gamL[63];
        bf16* Qd = (bf16*)(a.ws + WS_QD) + (size_t)unit * 4096; bf16* KdT = (bf16*)(a.ws + WS_KDT) + (size_t)unit * 4096;
#pragma unroll 1
        for (int e = t2; e < 512; e += 128) { const int tok = e >> 3, sub = e & 7; const float sc = __expf(gamL[tok]);
            const u32x4 v = *(const u32x4*)(qbf + tok * 72 + sub * 8);
            u32x4 o; o.x = pk2(bflo(v.x) * sc, bfhi(v.x) * sc); o.y = pk2(bflo(v.y) * sc, bfhi(v.y) * sc); o.z = pk2(bflo(v.z) * sc, bfhi(v.z) * sc); o.w = pk2(bflo(v.w) * sc, bfhi(v.w) * sc);
            *(u32x4*)(Qd + tok * 64 + sub * 8) = o; }
#pragma unroll 1
        for (int e = t2; e < 512; e += 128) { const int dk = e & 63, tg = e >> 6; float v[8];
#pragma unroll
            for (int tt = 0; tt < 8; ++tt) { const int tok = tg * 8 + tt; v[tt] = bf2f(kbf[tok * 72 + dk]) * __expf(glast - gamL[tok]); }
            u32x4 o; o.x = pk2(v[0], v[1]); o.y = pk2(v[2], v[3]); o.z = pk2(v[4], v[5]); o.w = pk2(v[6], v[7]);
            *(u32x4*)(KdT + dk * 64 + tg * 8) = o; }
        if (t2 == 0) ((float*)(a.ws + WS_GTOT))[unit] = __expf(glast);
    }
    __syncthreads();
    if (tid4 < 64) {
        u32x4* ub = (u32x4*)((bf16*)(a.ws + WS_UBT) + (size_t)unit * 4096 + tid4 * 64);
#pragma unroll
        for (int g = 0; g < 8; ++g) ub[g] = (u32x4){pk2(x[8 * g], x[8 * g + 1]), pk2(x[8 * g + 2], x[8 * g + 3]), pk2(x[8 * g + 4], x[8 * g + 5]), pk2(x[8 * g + 6], x[8 * g + 7])};
    } else if (tid4 < 128) {
        const int cc = tid4 - 64;
#pragma unroll
        for (int i = 0; i < 64; ++i) Wl[i * 72 + cc] = f2bf(-x[i]);
    }
    __syncthreads();
    {
        bf16* Wn = (bf16*)(a.ws + WS_WN) + (size_t)unit * 4096;
#pragma unroll
        for (int e = tid4; e < 512; e += 256) { const int tok = e >> 3, sub = e & 7; *(u32x4*)(Wn + tok * 64 + sub * 8) = *(const u32x4*)(Wl + tok * 72 + sub * 8); }
    }
}

__device__ __forceinline__ void m1_sgu(const KArgs& a, int l, int unit, unsigned char* lds) {
    const int tid = opaque_tid(), lane = tid & 63, wave = tid >> 6, r = lane & 15, q = lane >> 4;
    const int b = unit >> 6, n = unit & 63, row0 = b * SEQ + n * 128;
    const bf16* HP = (const bf16*)(a.ws + WS_HP);
    bf16* vnT = (bf16*)lds;
    const float* lg = a.in[7] + l * 256; const float* lb = a.in[8] + l * 256;
    float gch[4], bch[4];
#pragma unroll
    for (int i = 0; i < 4; ++i) { gch[i] = lg[lane + 64 * i]; bch[i] = lb[lane + 64 * i]; }
#pragma unroll 4
    for (int tt = 0; tt < 16; ++tt) {
        const int tok = wave * 16 + tt; const bf16* src = HP + (size_t)(row0 + tok) * DINP + C_AV;
        float v[4]; float s = 0.f;
#pragma unroll
        for (int i = 0; i < 4; ++i) { v[i] = bf2f(src[lane + 64 * i]); s += v[i]; }
        const float mean = wave_sum(s) * (1.f / 256.f); float s2 = 0.f;
#pragma unroll
        for (int i = 0; i < 4; ++i) { v[i] -= mean; s2 += v[i] * v[i]; }
        const float rstd = rsqrtf(wave_sum(s2) * (1.f / 256.f) + EPS);
#pragma unroll
        for (int i = 0; i < 4; ++i) vnT[(lane + 64 * i) * 136 + tok] = f2bf(v[i] * rstd * gch[i] + bch[i]);
    }
    __syncthreads();
    const int h = wave >> 1, ih = wave & 1;
    const bf16* Wm = (const bf16*)(a.ws + WS_W + OWM) + h * 16384;
    f32x4 acc[4][4];
#pragma unroll
    for (int it = 0; it < 4; ++it)
#pragma unroll
        for (int dt = 0; dt < 4; ++dt) acc[it][dt] = (f32x4){0.f, 0.f, 0.f, 0.f};
#pragma unroll
    for (int ks = 0; ks < 4; ++ks) {
        if (32 * ks <= 64 * ih + 63) {
            bf16x8 av[4];
#pragma unroll
            for (int dt = 0; dt < 4; ++dt) av[dt] = *(const bf16x8*)(vnT + (h * 64 + 16 * dt + r) * 136 + 32 * ks + 8 * q);
#pragma unroll
            for (int it = 0; it < 4; ++it) {
                const bf16x8 bw = *(const bf16x8*)(Wm + (64 * ih + 16 * it + r) * 128 + 32 * ks + 8 * q);
#pragma unroll
                for (int dt = 0; dt < 4; ++dt) acc[it][dt] = mfma16(av[dt], bw, acc[it][dt]);
            }
        }
    }
    const float* sb = a.in[10] + (size_t)l * 512 + h * 128;
    bf16* MIX = (bf16*)(a.ws + WS_MIX);
#pragma unroll
    for (int it = 0; it < 4; ++it) {
        const int tok = 64 * ih + 16 * it + r; const float bias = sb[tok];
#pragma unroll
        for (int dt = 0; dt < 4; ++dt) {
            const int d0 = h * 64 + 16 * dt + 4 * q;
            const u32x2 uv = *(const u32x2*)(HP + (size_t)(row0 + tok) * DINP + C_AU + d0);
            f32x4 z = acc[it][dt]; if (!(MIXSEL & 1)) z = (f32x4){0.f, 0.f, 0.f, 0.f};
            *(u32x2*)(MIX + (size_t)(row0 + tok) * D + d0) = (u32x2){pk2(bflo(uv.x) * (z[0] + bias), bfhi(uv.x) * (z[1] + bias)), pk2(bflo(uv.y) * (z[2] + bias), bfhi(uv.y) * (z[3] + bias))};
        }
    }
}

__device__ __forceinline__ void m1_gla(const KArgs& a, int l, int item, unsigned char* lds) {
    const int tid = opaque_tid(), lane = tid & 63, wave = tid >> 6, r = lane & 15, q = lane >> 4;
    const int unit = item * 8 + wave, b = unit >> 9, h = (unit >> 7) & 3, n = unit & 127, row0 = b * SEQ + n * 64;
    unsigned char* wl = lds + wave * 14336;
    bf16* qdL = (bf16*)wl; bf16* knL = (bf16*)(wl + 5120);
    bf16* vT = (bf16*)wl; bf16* kdT = (bf16*)(wl + 9216);
    const bf16* HP = (const bf16*)(a.ws + WS_HP);
    const int dk = lane & 31, half = lane >> 5;
    float gu[16];
#pragma unroll
    for (int i = 0; i < 16; ++i) gu[i] = a.in[15][(size_t)l * 2048 + i * 128 + h * 32 + dk];
    const float gb = a.in[16][l * 128 + h * 32 + dk];
    float bc[32];
#pragma unroll
    for (int t = 0; t < 32; ++t) {
        const int tok = half * 32 + t; const u32x4* gp = (const u32x4*)(HP + (size_t)(row0 + tok) * DINP + C_CG);
        const u32x4 g0 = gp[0], g1 = gp[1];
        float dot = gb;
        dot += bflo(g0.x) * gu[0] + bfhi(g0.x) * gu[1] + bflo(g0.y) * gu[2] + bfhi(g0.y) * gu[3] + bflo(g0.z) * gu[4] + bfhi(g0.z) * gu[5] + bflo(g0.w) * gu[6] + bfhi(g0.w) * gu[7];
        dot += bflo(g1.x) * gu[8] + bfhi(g1.x) * gu[9] + bflo(g1.y) * gu[10] + bfhi(g1.y) * gu[11] + bflo(g1.z) * gu[12] + bfhi(g1.z) * gu[13] + bflo(g1.w) * gu[14] + bfhi(g1.w) * gu[15];
        const float la = -softplusf(-dot) * (1.f / 16.f);
        bc[t] = (t ? bc[t - 1] : 0.f) + la;
    }
    const float tot0 = __shfl(bc[31], dk);
    if (half) {
#pragma unroll
        for (int t = 0; t < 32; ++t) bc[t] += tot0;
    }
    const float blast = __shfl(bc[31], dk + 32);
    bf16* QdG = (bf16*)(a.ws + WS_QDG) + (size_t)unit * 2048;
    unsigned kdp[16];
#pragma unroll
    for (int t = 0; t < 32; t += 2) {
        float kd2[2];
#pragma unroll
        for (int u = 0; u < 2; ++u) {
            const int tok = half * 32 + t + u; const size_t ro = (size_t)(row0 + tok) * DINP;
            const float qv = bf2f(HP[ro + C_CQ + h * 32 + dk]), kv = bf2f(HP[ro + C_CK + h * 32 + dk]);
            const float bcv = bc[t + u];
            const bf16 qd = f2bf(qv * 0.17677669529663687f * __expf(bcv));
            qdL[tok * 40 + dk] = qd; QdG[tok * 32 + dk] = qd;
            knL[tok * 40 + dk] = f2bf(kv * __expf(-bcv));
            kd2[u] = kv * __expf(blast - bcv);
        }
        kdp[t >> 1] = pk2(kd2[0], kd2[1]);
    }
    if (half) ((float*)(a.ws + WS_GT))[unit * 32 + dk] = __expf(blast);
    asm volatile("s_waitcnt lgkmcnt(0)" ::: "memory");
    u32x2 pp[4][4];
#pragma unroll
    for (int it = 0; it < 4; ++it) {
        const bf16x8 qf = *(const bf16x8*)(qdL + (16 * it + r) * 40 + 8 * q);
#pragma unroll
        for (int jt = 0; jt < 4; ++jt) {
            pp[it][jt] = (u32x2){0u, 0u};
            if (jt <= it) {
                const bf16x8 kf = *(const bf16x8*)(knL + (16 * jt + r) * 40 + 8 * q);
                f32x4 pc = {0.f, 0.f, 0.f, 0.f};
                pc = mfma16(kf, qf, pc);
                const int i = 16 * it + r; float pv[4];
#pragma unroll
                for (int jj = 0; jj < 4; ++jj) { const int j = 16 * jt + 4 * q + jj; pv[jj] = (j <= i) ? pc[jj] : 0.f; }
                pp[it][jt] = (u32x2){pk2(pv[0], pv[1]), pk2(pv[2], pv[3])};
            }
        }
    }
    asm volatile("s_waitcnt lgkmcnt(0)" ::: "memory");
#pragma unroll
    for (int t = 0; t < 32; t += 2) { const int tok = half * 32 + t; *(unsigned*)(kdT + dk * 72 + tok) = kdp[t >> 1]; }
#pragma unroll 2
    for (int it = 0; it < 8; ++it) {
        const int e = it * 64 + lane, tok = e >> 3, g = e & 7;
        const u32x4 v = *(const u32x4*)(HP + (size_t)(row0 + tok) * DINP + C_CV + h * 64 + g * 8);
        bf16* d = vT + (g * 8) * 72 + tok;
        d[0] = (bf16)(v.x & 0xffffu); d[72] = (bf16)(v.x >> 16); d[144] = (bf16)(v.y & 0xffffu); d[216] = (bf16)(v.y >> 16);
        d[288] = (bf16)(v.z & 0xffffu); d[360] = (bf16)(v.z >> 16); d[432] = (bf16)(v.w & 0xffffu); d[504] = (bf16)(v.w >> 16);
    }
    asm volatile("s_waitcnt lgkmcnt(0)" ::: "memory");
    f32x4* OiT = (f32x4*)(a.ws + WS_OIT) + (size_t)unit * 1024 + lane;
#pragma unroll
    for (int dt = 0; dt < 4; ++dt) {
        bf16x8 va[2];
#pragma unroll
        for (int ks = 0; ks < 2; ++ks) va[ks] = mk8(*(const u32x2*)(vT + (16 * dt + r) * 72 + 32 * ks + 4 * q), *(const u32x2*)(vT + (16 * dt + r) * 72 + 32 * ks + 16 + 4 * q));
#pragma unroll
        for (int it = 0; it < 4; ++it) {
            f32x4 acc = {0.f, 0.f, 0.f, 0.f};
            acc = mfma16(va[0], mk8(pp[it][0], pp[it][1]), acc);
            if (it >= 2) acc = mfma16(va[1], mk8(pp[it][2], pp[it][3]), acc);
            OiT[(it * 4 + dt) * 64] = acc;
        }
    }
    float* BnT = (float*)(a.ws + WS_BNT) + (size_t)unit * 2048;
#pragma unroll
    for (int dt = 0; dt < 4; ++dt) {
        bf16x8 va[2];
#pragma unroll
        for (int ks = 0; ks < 2; ++ks) va[ks] = *(const bf16x8*)(vT + (16 * dt + r) * 72 + 32 * ks + 8 * q);
#pragma unroll
        for (int kt = 0; kt < 2; ++kt) {
            f32x4 acc = {0.f, 0.f, 0.f, 0.f};
#pragma unroll
            for (int ks = 0; ks < 2; ++ks) acc = mfma16(va[ks], *(const bf16x8*)(kdT + (16 * kt + r) * 72 + 32 * ks + 8 * q), acc);
#pragma unroll
            for (int i = 0; i < 4; ++i) BnT[(16 * dt + 4 * q + i) * 32 + 16 * kt + r] = acc[i];
        }
    }
}

__device__ __forceinline__ void phase_m1(const KArgs& a, int l, unsigned char* lds) {
    for (int item = opaque_bid(); item < 1280; item += gridDim.x) {
        __syncthreads();
        if (item < 1024) m1_gdn(a, l, item, lds);
        else if (item < 1152) m1_sgu(a, l, item - 1024, lds);
        else m1_gla(a, l, item - 1152, lds);
    }
}
__device__ __forceinline__ void phase_m2(const KArgs& a) {
    const int tid = opaque_tid(), lane = tid & 63, wave = tid >> 6, r = lane & 15, q = lane >> 4;
    const int blk = opaque_bid();
    if (blk < 64) {
        if (wave != 0) return;
        const int b = blk >> 5, h = (blk >> 2) & 7, s = blk & 3;
        const int u0 = (b * 8 + h) * 128;
        const bf16* Wn = (const bf16*)(a.ws + WS_WN); const bf16* KdT = (const bf16*)(a.ws + WS_KDT); const bf16* ubT = (const bf16*)(a.ws + WS_UBT);
        const float* Gtot = (const float*)(a.ws + WS_GTOT);
        u32x4* SP = (u32x4*)(a.ws + WS_SP); u32x4* UF = (u32x4*)(a.ws + WS_UF);
        f32x4 S[4];
#pragma unroll
        for (int mt = 0; mt < 4; ++mt) S[mt] = (f32x4){0.f, 0.f, 0.f, 0.f};
        u32x2 wlo[4][2], whi[4][2], klo[4][2], khi[4][2], ubv[4]; float g;
#define M2_LOAD(uidx) do { const bf16* wp = Wn + (size_t)(uidx) * 4096; const bf16* kp = KdT + (size_t)(uidx) * 4096; const bf16* up = ubT + (size_t)(uidx) * 4096; \
        _Pragma("unroll") for (int t = 0; t < 4; ++t) { _Pragma("unroll") for (int ks = 0; ks < 2; ++ks) { \
            wlo[t][ks] = *(const u32x2*)(wp + (16 * t + r) * 64 + 32 * ks + 4 * q); whi[t][ks] = *(const u32x2*)(wp + (16 * t + r) * 64 + 32 * ks + 16 + 4 * q); \
            klo[t][ks] = *(const u32x2*)(kp + (16 * t + r) * 64 + 32 * ks + 4 * q); khi[t][ks] = *(const u32x2*)(kp + (16 * t + r) * 64 + 32 * ks + 16 + 4 * q); } \
            ubv[t] = *(const u32x2*)(up + (16 * s + r) * 64 + 16 * t + 4 * q); } \
        g = Gtot[uidx]; } while (0)
        M2_LOAD(u0);
#pragma unroll 1
        for (int n = 0; n < 128; ++n) {
            const int uidx = u0 + n;
            bf16x8 wa[4][2], ka[4][2]; f32x4 u[4]; const float gc = g;
#pragma unroll
            for (int t = 0; t < 4; ++t) {
#pragma unroll
                for (int ks = 0; ks < 2; ++ks) { wa[t][ks] = mk8(wlo[t][ks], whi[t][ks]); ka[t][ks] = mk8(klo[t][ks], khi[t][ks]); }
                u[t] = (f32x4){bflo(ubv[t].x), bfhi(ubv[t].x), bflo(ubv[t].y), bfhi(ubv[t].y)};
            }
            if (n + 1 < 128) M2_LOAD(uidx + 1);
            u32x4 sb[2];
#pragma unroll
            for (int ks = 0; ks < 2; ++ks) sb[ks] = (u32x4){pk2(S[2 * ks][0], S[2 * ks][1]), pk2(S[2 * ks][2], S[2 * ks][3]), pk2(S[2 * ks + 1][0], S[2 * ks + 1][1]), pk2(S[2 * ks + 1][2], S[2 * ks + 1][3])};
            SP[((size_t)(uidx * 4 + s) * 2 + 0) * 64 + lane] = sb[0]; SP[((size_t)(uidx * 4 + s) * 2 + 1) * 64 + lane] = sb[1];
#pragma unroll
            for (int ks = 0; ks < 2; ++ks)
#pragma unroll
                for (int t = 0; t < 4; ++t) u[t] = mfma16(wa[t][ks], as8(sb[ks]), u[t]);
            u32x4 up2[2];
#pragma unroll
            for (int ks = 0; ks < 2; ++ks) up2[ks] = (u32x4){pk2(u[2 * ks][0], u[2 * ks][1]), pk2(u[2 * ks][2], u[2 * ks][3]), pk2(u[2 * ks + 1][0], u[2 * ks + 1][1]), pk2(u[2 * ks + 1][2], u[2 * ks + 1][3])};
            UF[((size_t)(uidx * 4 + s) * 2 + 0) * 64 + lane] = up2[0]; UF[((size_t)(uidx * 4 + s) * 2 + 1) * 64 + lane] = up2[1];
#pragma unroll
            for (int t = 0; t < 4; ++t) S[t] = S[t] * gc;
#pragma unroll
            for (int ks = 0; ks < 2; ++ks)
#pragma unroll
                for (int t = 0; t < 4; ++t) S[t] = mfma16(ka[t][ks], as8(up2[ks]), S[t]);
        }
#undef M2_LOAD
    } else if (blk < 96) {
        const int gid = (blk - 64) * 512 + tid, bh = gid >> 11, rem = gid & 2047;
        const int dk = rem & 31;
        const float* BnT = (const float*)(a.ws + WS_BNT) + (size_t)bh * 128 * 2048 + rem;
        const float* Gt = (const float*)(a.ws + WS_GT) + (size_t)bh * 128 * 32 + dk;
        bf16* ST = (bf16*)(a.ws + WS_ST) + (size_t)bh * 128 * 2048 + rem;
        float S = 0.f;
#pragma unroll 1
        for (int n0 = 0; n0 < 128; n0 += 8) {
            float bn[8], gt[8];
#pragma unroll
            for (int i = 0; i < 8; ++i) { bn[i] = BnT[(size_t)(n0 + i) * 2048]; gt[i] = Gt[(n0 + i) * 32]; }
#pragma unroll
            for (int i = 0; i < 8; ++i) { ST[(size_t)(n0 + i) * 2048] = f2bf(S); S = gt[i] * S + bn[i]; }
        }
    }
}

__device__ __forceinline__ void phase_m3(const KArgs& a, int l) {
    const int tid = opaque_tid(), lane = tid & 63, wave = tid >> 6, r = lane & 15, q = lane >> 4;
    const int gw = opaque_bid() * 8 + wave, NGW = gridDim.x * 8;
    const bf16* HP = (const bf16*)(a.ws + WS_HP); bf16* MIX = (bf16*)(a.ws + WS_MIX);
#pragma unroll 1
    for (int wi = gw; wi < 12288; wi += NGW) {
        f32x4 acc[4]; int row, zc, oc; const float* ng;
        if (wi < 8192) {
            const int unit = wi >> 2, it = wi & 3, b = unit >> 10, h = (unit >> 7) & 7, n = unit & 127;
            const bf16* Qd = (const bf16*)(a.ws + WS_QD) + (size_t)unit * 4096 + (16 * it + r) * 64;
            bf16x8 qa[2], pa[2];
#pragma unroll
            for (int ks = 0; ks < 2; ++ks) { qa[ks] = mk8(*(const u32x2*)(Qd + 32 * ks + 4 * q), *(const u32x2*)(Qd + 32 * ks + 16 + 4 * q));
                pa[ks] = as8(((const u32x4*)(a.ws + WS_PF))[((size_t)(unit * 4 + it) * 2 + ks) * 64 + lane]); }
#pragma unroll
            for (int dt = 0; dt < 4; ++dt) {
                f32x4 c = {0.f, 0.f, 0.f, 0.f};
#pragma unroll
                for (int ks = 0; ks < 2; ++ks) {
                    const bf16x8 sf = as8(((const u32x4*)(a.ws + WS_SP))[((size_t)(unit * 4 + dt) * 2 + ks) * 64 + lane]);
                    const bf16x8 uf = as8(((const u32x4*)(a.ws + WS_UF))[((size_t)(unit * 4 + dt) * 2 + ks) * 64 + lane]);
                    c = mfma16(sf, qa[ks], c); c = mfma16(uf, pa[ks], c);
                }
                acc[dt] = c;
            }
            row = b * SEQ + n * 64 + 16 * it + r; zc = C_BZ + h * 64; oc = 256 + h * 64; ng = a.in[14] + l * 64;
        } else {
            const int w2 = wi - 8192, unit = w2 >> 2, it = w2 & 3, b = unit >> 9, h = (unit >> 7) & 3, n = unit & 127;
            const bf16x8 qa = *(const bf16x8*)((const bf16*)(a.ws + WS_QDG) + (size_t)unit * 2048 + (16 * it + r) * 32 + 8 * q);
            const f32x4* OiT = (const f32x4*)(a.ws + WS_OIT) + (size_t)unit * 1024 + lane;
            const bf16* ST = (const bf16*)(a.ws + WS_ST) + (size_t)unit * 2048;
#pragma unroll
            for (int dt = 0; dt < 4; ++dt) {
                const bf16x8 sa = *(const bf16x8*)(ST + (16 * dt + r) * 32 + 8 * q);
#if GLA_DBG == 1
                acc[dt] = OiT[(it * 4 + dt) * 64];
#elif GLA_DBG == 2
                acc[dt] = mfma16(sa, qa, (f32x4){0.f, 0.f, 0.f, 0.f});
#else
                acc[dt] = mfma16(sa, qa, OiT[(it * 4 + dt) * 64]);
#endif
            }
            row = b * SEQ + n * 64 + 16 * it + r; zc = C_CR + h * 64; oc = 768 + h * 64; ng = a.in[17] + l * 64;
        }
        if ((wi < 8192) ? !(MIXSEL & 2) : !(MIXSEL & 4)) { for (int dt = 0; dt < 4; ++dt) acc[dt] = (f32x4){0.f, 0.f, 0.f, 0.f}; }
        float ss = 0.f;
#pragma unroll
        for (int dt = 0; dt < 4; ++dt) ss += (acc[dt][0] * acc[dt][0] + acc[dt][1] * acc[dt][1]) + (acc[dt][2] * acc[dt][2] + acc[dt][3] * acc[dt][3]);
        ss += __shfl_xor(ss, 16); ss += __shfl_xor(ss, 32);
        const float rs = rsqrtf(ss * (1.f / 64.f) + EPS);
#pragma unroll
        for (int dt = 0; dt < 4; ++dt) {
            const int d0 = 16 * dt + 4 * q;
            const u32x2 zv = *(const u32x2*)(HP + (size_t)row * DINP + zc + d0);
            const f32x4 gn = *(const f32x4*)(ng + d0);
            const float z0 = bflo(zv.x), z1 = bfhi(zv.x), z2 = bflo(zv.y), z3 = bfhi(zv.y);
            const float o0 = acc[dt][0] * rs * gn.x * z0 * sigm(z0), o1 = acc[dt][1] * rs * gn.y * z1 * sigm(z1), o2 = acc[dt][2] * rs * gn.z * z2 * sigm(z2), o3 = acc[dt][3] * rs * gn.w * z3 * sigm(z3);
            *(u32x2*)(MIX + (size_t)row * D + oc + d0) = (u32x2){pk2(o0, o1), pk2(o2, o3)};
        }
    }
}

__global__ void __launch_bounds__(512, 2) mk_fwd(KArgs a) {
    extern __shared__ __attribute__((aligned(16))) unsigned char lds[];
    cg::grid_group grid = cg::this_grid();
    for (int ph = a.lo; ph < a.hi; ++ph) {
        const int l = ph / NPH, k = ph - l * NPH;
        unsigned char* ws = a.ws; asm volatile("" : "+s"(ws));
        const bf16* XB = (const bf16*)(ws + WS_XB); bf16* HB = (bf16*)(ws + WS_HP);
        if (k == 0) phase_conv(a, l, lds);
        else if (k == 1 || k == 10) {
            pg8::Gemm g{XB, (const bf16*)(ws + WS_W + (k == 1 ? OW13A : OW13B)), M, 2 * FF, D}; pg8::StaticOrder S; S.init(M, 2 * FF, gridDim.x, opaque_bid());
            pg8::EpiSwiglu E{HB, FF};
            pg8::gemm_phase<pg8::EpiSwiglu, pg8::StaticOrder, true, true>((LAS unsigned char*)lds, g, S, E);
        } else if (k == 2 || k == 11 || k == 8) {
            pg8::Gemm g; pg8::EpiRes E{a.out, D, ALPHA, 0.5f};
            if (k == 8) { g = pg8::Gemm{(const bf16*)(ws + WS_MIX), (const bf16*)(ws + WS_W + OWOUT), M, D, D}; E.cs = 1.0f; }
            else g = pg8::Gemm{HB, (const bf16*)(ws + WS_W + (k == 2 ? OW2A : OW2B)), M, D, FF};
            pg8::StaticOrder S; S.init(M, D, gridDim.x, opaque_bid());
            pg8::gemm_phase<pg8::EpiRes, pg8::StaticOrder, true, true>((LAS unsigned char*)lds, g, S, E);
        } else if (k == 3 || k == 9 || k == 12) {
            const int gi = (k == 3) ? 4 : (k == 9 ? 19 : 24);
            phase_ln(a, a.in[gi] + l * D, a.in[gi + 1] + l * D);
        } else if (k == 4) {
            pg8::Gemm g{XB, (const bf16*)(ws + WS_W + OWIN), M, DINP, D}; pg8::StaticOrder S; S.init(M, DINP, gridDim.x, opaque_bid());
            pg8::EpiProj E{HB, DINP, 2};
            pg8::gemm_phase<pg8::EpiProj, pg8::StaticOrder, true, true>((LAS unsigned char*)lds, g, S, E);
        } else if (k == 5) phase_m1(a, l, lds);
        else if (k == 6) phase_m2(a);
        else phase_m3(a, l);
        if (ph + 1 < a.hi) grid.sync();
    }
}

extern "C" void kernel_launch(void* const* d_in, const int* in_sizes, int n_in, void* d_out, int out_size, void* d_ws, size_t ws_size, hipStream_t stream) {
    static int grid = 0;
    if (grid == 0) {
        if (n_in != 26 || out_size != M * D || ws_size < WS_END) { fprintf(stderr, "kernel_launch: unexpected sizes n_in %d out %d ws %zu\n", n_in, out_size, ws_size); grid = -1; return; }
        int dev = 0, cus = 0;
        if (hipGetDevice(&dev) != hipSuccess || hipDeviceGetAttribute(&cus, hipDeviceAttributeMultiprocessorCount, dev) != hipSuccess) { grid = -1; return; }
        if (hipFuncSetAttribute((const void*)mk_fwd, hipFuncAttributeMaxDynamicSharedMemorySize, LDS_BYTES) != hipSuccess) { fprintf(stderr, "kernel_launch: hipFuncSetAttribute failed\n"); grid = -1; return; }
        grid = cus;
    }
    if (grid < 0) return;
    KArgs a{};
    for (int i = 0; i < 26; ++i) a.in[i] = (const float*)d_in[i];
    a.out = (float*)d_out; a.ws = (unsigned char*)d_ws;
#if ONE_LAUNCH
    a.lo = 0; a.hi = PH_HI;
    void* args[] = {&a};
    hipError_t e = hipLaunchCooperativeKernel((const void*)mk_fwd, dim3(grid), dim3(512), args, LDS_BYTES, stream);
    if (e != hipSuccess) fprintf(stderr, "cooperative launch failed: %s\n", hipGetErrorString(e));
#else
    for (int ph = 0; ph < PH_HI; ++ph) { a.lo = ph; a.hi = ph + 1; hipLaunchKernelGGL(mk_fwd, dim3(grid), dim3(512), LDS_BYTES, stream, a); }
#endif
}
```

```cpp
#include <hip/hip_runtime.h>
#define GLA_DBG 0
#include <hip/hip_cooperative_groups.h>
#include <cstdio>
#include <cstdint>
namespace cg = cooperative_groups;
__device__ __forceinline__ int opaque_tid() { int t = threadIdx.x; asm volatile("" : "+v"(t)); return t; }
__device__ __forceinline__ int opaque_bid() { int b = blockIdx.x; asm volatile("" : "+s"(b)); return b; }
namespace pg8 {
#define PG8_LAS __attribute__((address_space(3)))
typedef unsigned short bf16_t;
typedef short bf16x8 __attribute__((ext_vector_type(8)));
typedef float f32x4 __attribute__((ext_vector_type(4)));
typedef unsigned u32x4 __attribute__((ext_vector_type(4)));
constexpr int BM = 256, BK = 64, HALF = 128, HTB = HALF * BK * 2  , STAGE_BYTES = 8 * HTB, NXCD = 8, WGM = 8;

__host__ __device__ __forceinline__ int lds_byte(int r, int c) { const int st = (r >> 4) * 2 + (c >> 5), rr = r & 15, cc = c & 31, ob = rr * 64 + cc * 2; return st * 1024 + (ob ^ (((ob >> 9) & 1) << 5)); }
__host__ __device__ __forceinline__ void stage_rc(int b, int& R, int& C) { const int st = b / 1024, sb = b % 1024, swz = sb ^ (((sb >> 9) & 1) << 5); R = (st >> 1) * 16 + swz / 64; C = (st & 1) * 32 + (swz % 64) / 2; }
__host__ __device__ __forceinline__ int perm32(int rho) { const int n = rho >> 4, i = rho & 15; return 8 * (i >> 2) + 4 * n + (i & 3); }

struct Unit { int pm, pn; };
struct Gemm { const bf16_t* A; const bf16_t* Bt; int M, N, K; };

struct StaticOrder {
    int nM, nN, nwg, G, c;
    __host__ __device__ void init(int M, int N, int G_, int c_) { nM = M / BM; nN = N / BM; nwg = nM * nN; G = G_; c = c_; }
    __host__ __device__ bool next(int i, Unit& u) const {
        const long L = (long)i * G + c; if (L >= nwg) return false;
        int wgid = (int)L; { const int q = nwg / NXCD, r = nwg % NXCD, xcd = wgid % NXCD, off = wgid / NXCD; wgid = (xcd < r ? xcd * (q + 1) : r * (q + 1) + (xcd - r) * q) + off; }
        const int nig = WGM * nN, gid = wgid / nig, fm = gid * WGM, gsz = (nM - fm) < WGM ? (nM - fm) : WGM;
        u.pm = fm + ((wgid % nig) % gsz); u.pn = (wgid % nig) / gsz; return true;
    }
    __device__ __forceinline__ void a_ready(const Unit&) const {}
    __device__ __forceinline__ void done(const Unit&) const {}
};

__device__ __forceinline__ unsigned cvt_pk_bf16(float lo, float hi) { unsigned r; asm volatile("v_cvt_pk_bf16_f32 %0, %1, %2" : "=v"(r) : "v"(lo), "v"(hi)); return r; }
typedef float f32x2 __attribute__((ext_vector_type(2)));
__device__ __forceinline__ f32x2 gelu_pk(f32x2 v) {
    const f32x2 av = __builtin_elementwise_abs(v), d = av * 0.2316418882f + 1.0f;
    f32x2 t; t.x = __builtin_amdgcn_rcpf(d.x); t.y = __builtin_amdgcn_rcpf(d.y);
    f32x2 q = t * 0.5307027145f + (-0.7265760135f); q = q * t + 0.7107068705f; q = q * t + (-0.142248368f); q = q * t + 0.127414796f; q = q * t;
    const f32x2 s = (v * v) * (-0.72134752044f);
    f32x2 e; e.x = __builtin_amdgcn_exp2f(s.x); e.y = __builtin_amdgcn_exp2f(s.y);
    const f32x2 m = v * (q * e), r = v - m;
    f32x2 o; o.x = v.x < 0.f ? m.x : r.x; o.y = v.y < 0.f ? m.y : r.y; return o;
}

template <int ACT  > struct EpiBf16 {
    static constexpr bool PERM = true, AFTER_DRAIN = false; static_assert(ACT == 0 || ACT == 1, "EpiBf16: ACT is 0 (none) or 1 (gelu_pk)");
    bf16_t* O; int ldc; const float* bias; int split_cols; size_t split_stride; float scale0;
    __device__ __forceinline__ void operator()(const f32x4 (&acc)[2][2][4][2], const Unit& u, int wr, int wc, int fr, int fq) const {
        const int row0 = u.pm * BM + wr * 64 + fr; int colt = u.pn * BM; bf16_t* base = O;
        float sc = 1.f; if (split_cols) { const int t = colt / split_cols; base += (size_t)t * split_stride; colt -= t * split_cols; if (t == 0) sc = scale0; }
        const int col0 = colt + wc * 32 + 8 * fq, bcol0 = u.pn * BM + wc * 32 + 8 * fq;
        f32x4 bv[2][2];
#pragma unroll
        for (int bj = 0; bj < 2; ++bj)
#pragma unroll
            for (int n = 0; n < 2; ++n) bv[bj][n] = bias ? *(const f32x4*)(bias + bcol0 + bj * HALF + 4 * n) : (f32x4){0.f, 0.f, 0.f, 0.f};
#pragma unroll
        for (int ai = 0; ai < 2; ++ai)
#pragma unroll
            for (int m = 0; m < 4; ++m) { bf16_t* rowp = base + (size_t)(row0 + ai * HALF + m * 16) * ldc + col0;
#pragma unroll
                for (int bj = 0; bj < 2; ++bj) { f32x4 v0 = acc[ai][bj][m][0] + bv[bj][0], v1 = acc[ai][bj][m][1] + bv[bj][1];
                    if (ACT == 1) { f32x2 a = gelu_pk((f32x2){v0[0], v0[1]}), b = gelu_pk((f32x2){v0[2], v0[3]}), c = gelu_pk((f32x2){v1[0], v1[1]}), d = gelu_pk((f32x2){v1[2], v1[3]});
                        v0 = (f32x4){a.x, a.y, b.x, b.y}; v1 = (f32x4){c.x, c.y, d.x, d.y}; }
                    v0 = v0 * sc; v1 = v1 * sc; u32x4 w; w.x = cvt_pk_bf16(v0[0], v0[1]); w.y = cvt_pk_bf16(v0[2], v0[3]); w.z = cvt_pk_bf16(v1[0], v1[1]); w.w = cvt_pk_bf16(v1[2], v1[3]);
                    *(u32x4*)(rowp + bj * HALF) = w; } }
    }
};
__device__ __forceinline__ float fast_sigmoid(float x) { return __builtin_amdgcn_rcpf(1.0f + __expf(-x)); }
struct EpiSwiglu {
    static constexpr bool PERM = true, AFTER_DRAIN = false;
    bf16_t* O; int ldc;
    __device__ __forceinline__ void operator()(const f32x4 (&acc)[2][2][4][2], const Unit& u, int wr, int wc, int fr, int fq) const {
        const int row0 = u.pm * BM + wr * 64 + fr; const int col0 = u.pn * HALF + wc * 32 + 8 * fq;
#pragma unroll
        for (int ai = 0; ai < 2; ++ai)
#pragma unroll
            for (int m = 0; m < 4; ++m) { bf16_t* rowp = O + (size_t)(row0 + ai * HALF + m * 16) * ldc + col0;
                float h[8];
#pragma unroll
                for (int n = 0; n < 2; ++n)
#pragma unroll
                    for (int i = 0; i < 4; ++i) { const float g = acc[ai][0][m][n][i], up = acc[ai][1][m][n][i]; h[n * 4 + i] = g * fast_sigmoid(g) * up; }
                u32x4 w; w.x = cvt_pk_bf16(h[0], h[1]); w.y = cvt_pk_bf16(h[2], h[3]); w.z = cvt_pk_bf16(h[4], h[5]); w.w = cvt_pk_bf16(h[6], h[7]);
                *(u32x4*)rowp = w; }
    }
};
struct EpiProj {
    static constexpr bool PERM = true, AFTER_DRAIN = false;
    bf16_t* O; int ldc; int gelu_tiles;
    __device__ __forceinline__ void operator()(const f32x4 (&acc)[2][2][4][2], const Unit& u, int wr, int wc, int fr, int fq) const {
        const int row0 = u.pm * BM + wr * 64 + fr; const int col0 = u.pn * BM + wc * 32 + 8 * fq; const bool act = u.pn < gelu_tiles;
#pragma unroll
        for (int ai = 0; ai < 2; ++ai)
#pragma unroll
            for (int m = 0; m < 4; ++m) { bf16_t* rowp = O + (size_t)(row0 + ai * HALF + m * 16) * ldc + col0;
#pragma unroll
                for (int bj = 0; bj < 2; ++bj) { float h[8];
#pragma unroll
                    for (int n = 0; n < 2; ++n)
#pragma unroll
                        for (int i = 0; i < 4; ++i) { float v = acc[ai][bj][m][n][i];
                            if (act) { const float t = 1.5957691216f * (v + 0.044715f * v * v * v); v = v * fast_sigmoid(t); }
                            h[n * 4 + i] = v; }
                    u32x4 w; w.x = cvt_pk_bf16(h[0], h[1]); w.y = cvt_pk_bf16(h[2], h[3]); w.z = cvt_pk_bf16(h[4], h[5]); w.w = cvt_pk_bf16(h[6], h[7]);
                    *(u32x4*)(rowp + bj * HALF) = w; } }
    }
};
struct EpiRes {
    static constexpr bool PERM = false, AFTER_DRAIN = false;
    float* X; int ldc; float alpha, cs;
    __device__ __forceinline__ void operator()(const f32x4 (&acc)[2][2][4][2], const Unit& u, int wr, int wc, int fr, int fq) const {
        const int col0 = u.pn * BM + wc * 32 + 4 * fq;
#pragma unroll
        for (int ai = 0; ai < 2; ++ai)
#pragma unroll
            for (int m = 0; m < 4; ++m) { float* rowp = X + (size_t)(u.pm * BM + ai * HALF + wr * 64 + m * 16 + fr) * ldc + col0;
#pragma unroll
                for (int bj = 0; bj < 2; ++bj)
#pragma unroll
                    for (int n = 0; n < 2; ++n) { f32x4* p = (f32x4*)(rowp + bj * HALF + n * 16); const f32x4 b = *p; f32x4 o = b * alpha + acc[ai][bj][m][n] * cs;
#ifdef DBG_NANFILTER
                        for (int e = 0; e < 4; ++e) if (!(fabsf(o[e]) < 1e30f)) o[e] = 12345.0f;
#endif
                        *p = o; } }
    }
};
template <class Epi, class Sched, bool ALIGN_EPI = false, bool SP2 = false>
__device__ __forceinline__ void gemm_phase(PG8_LAS unsigned char* lds, const Gemm g, const Sched& S, const Epi& E) {
    const int tid = opaque_tid(), wid = __builtin_amdgcn_readfirstlane(tid >> 6), lane = tid & 63, wr = wid >> 2, wc = wid & 3, fr = lane & 15, fq = lane >> 4;
    const int K = g.K, nt = K / BK;
    unsigned voffA[2], voffB[2];
#pragma unroll
    for (int i = 0; i < 2; ++i) { int R, C; stage_rc(tid * 16 + i * 8192, R, C); const int Rb = Epi::PERM ? ((R & ~31) + perm32(R & 31)) : R;
        voffA[i] = (unsigned)(R * K + C) * 2u; voffB[i] = (unsigned)(Rb * K + C) * 2u; }
    const size_t kstep = (size_t)(BK * 2);
    const size_t hstep = (size_t)HALF * K * 2;
    const size_t tstep = 2 * hstep;
    const unsigned ldsw = (unsigned)wid * 1024u;
    const int aoff = lds_byte(wr * 64 + fr, fq * 8), boff = lds_byte(wc * 32 + fr, fq * 8);
#define PG8_SA(b, h) (((b) * 2 + (h)) * HTB)
#define PG8_SB(b, h) ((4 + (b) * 2 + (h)) * HTB)
#define PG8_STAGE(bufoff, gbase, voff) do { _Pragma("unroll") for (int _i = 0; _i < 2; ++_i) \
        __builtin_amdgcn_global_load_lds((const unsigned*)((const char*)(gbase) + (voff)[_i]), (PG8_LAS unsigned*)(lds + (bufoff) + ldsw + _i * 8192), 16, 0, 0); } while (0)
#define PG8_LDA(dst, b, h) do { _Pragma("unroll") for (int m = 0; m < 4; ++m) _Pragma("unroll") for (int k = 0; k < 2; ++k) dst[m][k] = *(const PG8_LAS bf16x8*)(lds + PG8_SA(b, h) + aoff + m * 2048 + k * 1024); } while (0)
#define PG8_LDB(dst, b, h) do { _Pragma("unroll") for (int n = 0; n < 2; ++n) _Pragma("unroll") for (int k = 0; k < 2; ++k) dst[n][k] = *(const PG8_LAS bf16x8*)(lds + PG8_SB(b, h) + boff + n * 2048 + k * 1024); } while (0)
#define PG8_MMA(ai, bj, At, Bt) do { __builtin_amdgcn_s_setprio(1); _Pragma("unroll") for (int m = 0; m < 4; ++m) _Pragma("unroll") for (int n = 0; n < 2; ++n) _Pragma("unroll") for (int k = 0; k < 2; ++k) \
        acc[ai][bj][m][n] = __builtin_amdgcn_mfma_f32_16x16x32_bf16(Bt[n][k], At[m][k], acc[ai][bj][m][n], 0, 0, 0); __builtin_amdgcn_s_setprio(0); } while (0)
#define PG8_WAIT_V(n) asm volatile("s_waitcnt vmcnt(" #n ")" ::: "memory")
#define PG8_WAIT_L(n) asm volatile("s_waitcnt lgkmcnt(" #n ")" ::: "memory")
#define PG8_BAR __builtin_amdgcn_s_barrier()
#define PG8_SCHED __builtin_amdgcn_sched_barrier(0)
    Unit cur, nxt; int ui = 0;
    if (!S.next(0, cur)) return;
    f32x4 acc[2][2][4][2];
#pragma unroll
    for (int a = 0; a < 2; ++a)
#pragma unroll
        for (int b = 0; b < 2; ++b)
#pragma unroll
            for (int m = 0; m < 4; ++m)
#pragma unroll
                for (int n = 0; n < 2; ++n) acc[a][b][m][n] = (f32x4){0.f, 0.f, 0.f, 0.f};
    bf16x8 At[4][2], B0[2][2], B1[2][2];
    const char* cA = (const char*)g.A + (size_t)cur.pm * tstep; const char* cB = (const char*)g.Bt + (size_t)cur.pn * tstep;
    S.a_ready(cur);
    if constexpr (SP2) {
        PG8_STAGE(PG8_SB(0, 0), cB, voffB); PG8_STAGE(PG8_SB(0, 1), cB + hstep, voffB); PG8_STAGE(PG8_SA(0, 0), cA, voffA); PG8_STAGE(PG8_SA(0, 1), cA + hstep, voffA);
        if (wr == 1) PG8_BAR;
        PG8_WAIT_V(2); PG8_BAR;
        PG8_STAGE(PG8_SB(1, 0), cB + kstep, voffB); PG8_STAGE(PG8_SA(1, 0), cA + kstep, voffA); PG8_STAGE(PG8_SB(1, 1), cB + hstep + kstep, voffB);
        PG8_WAIT_V(6); PG8_BAR;
    } else {
        PG8_STAGE(PG8_SB(0, 0), cB, voffB); PG8_STAGE(PG8_SA(0, 0), cA, voffA); PG8_STAGE(PG8_SB(0, 1), cB + hstep, voffB); PG8_STAGE(PG8_SA(0, 1), cA + hstep, voffA);
        if (wr == 1) PG8_BAR;
        PG8_WAIT_V(4); PG8_BAR;
        PG8_STAGE(PG8_SB(1, 0), cB + kstep, voffB); PG8_STAGE(PG8_SA(1, 0), cA + kstep, voffA); PG8_STAGE(PG8_SB(1, 1), cB + hstep + kstep, voffB);
        PG8_WAIT_V(6); PG8_BAR;
    }
    for (;;) {
        const bool has_next = S.next(ui + 1, nxt);
        const char* nA = has_next ? (const char*)g.A + (size_t)nxt.pm * tstep : cA; const char* nB = has_next ? (const char*)g.Bt + (size_t)nxt.pn * tstep : cB;
        for (int t = 0; t < nt; t += 2) {
            const bool last = (t == nt - 2);
            const char* a1 = cA + (size_t)(t + 1) * kstep;
            const char* a2 = last ? nA : cA + (size_t)(t + 2) * kstep; const char* b2 = last ? nB : cB + (size_t)(t + 2) * kstep;
            const char* a3 = a2 + kstep; const char* b3 = b2 + kstep;
            if (last && has_next) S.a_ready(nxt);
            if constexpr (SP2) {
            PG8_LDB(B0, 0, 0); PG8_LDB(B1, 0, 1); PG8_SCHED; PG8_LDA(At, 0, 0); PG8_STAGE(PG8_SA(1, 1), a1 + hstep, voffA);
            PG8_WAIT_V(8); PG8_WAIT_L(0); PG8_BAR; PG8_MMA(0, 0, At, B0); PG8_MMA(0, 1, At, B1); PG8_BAR; PG8_SCHED;
            PG8_LDA(At, 0, 1); PG8_STAGE(PG8_SB(0, 0), b2, voffB); PG8_STAGE(PG8_SB(0, 1), b2 + hstep, voffB); PG8_STAGE(PG8_SA(0, 0), a2, voffA);
            PG8_WAIT_V(8); PG8_WAIT_L(0); PG8_BAR; PG8_MMA(1, 0, At, B0); PG8_MMA(1, 1, At, B1); PG8_BAR; PG8_SCHED;
            PG8_LDB(B0, 1, 0); PG8_LDB(B1, 1, 1); PG8_SCHED; PG8_LDA(At, 1, 0); PG8_STAGE(PG8_SA(0, 1), a2 + hstep, voffA);
            PG8_WAIT_V(8); PG8_WAIT_L(0); PG8_BAR; PG8_MMA(0, 0, At, B0); PG8_MMA(0, 1, At, B1); PG8_BAR; PG8_SCHED;
            PG8_LDA(At, 1, 1); PG8_STAGE(PG8_SB(1, 0), b3, voffB); PG8_STAGE(PG8_SB(1, 1), b3 + hstep, voffB); PG8_STAGE(PG8_SA(1, 0), a3, voffA);
            PG8_WAIT_V(8); PG8_WAIT_L(0); PG8_BAR; PG8_MMA(1, 0, At, B0); PG8_MMA(1, 1, At, B1); PG8_BAR; PG8_SCHED;
            } else {
            PG8_LDB(B0, 0, 0); PG8_SCHED; PG8_LDA(At, 0, 0); PG8_STAGE(PG8_SA(1, 1), a1 + hstep, voffA);
            PG8_WAIT_L(8); PG8_BAR; PG8_WAIT_L(0); PG8_MMA(0, 0, At, B0); PG8_BAR; PG8_SCHED;
            PG8_LDB(B1, 0, 1); PG8_STAGE(PG8_SB(0, 0), b2, voffB);
            PG8_BAR; PG8_WAIT_L(0); PG8_MMA(0, 1, At, B1); PG8_BAR;
            PG8_LDA(At, 0, 1); PG8_STAGE(PG8_SA(0, 0), a2, voffA);
            PG8_BAR; PG8_WAIT_L(0); PG8_MMA(1, 0, At, B0); PG8_BAR; PG8_SCHED;
            PG8_STAGE(PG8_SB(0, 1), b2 + hstep, voffB);
            PG8_WAIT_V(6); PG8_BAR; PG8_MMA(1, 1, At, B1); PG8_BAR;
            PG8_LDB(B0, 1, 0); PG8_SCHED; PG8_LDA(At, 1, 0); PG8_STAGE(PG8_SA(0, 1), a2 + hstep, voffA);
            PG8_WAIT_L(8); PG8_BAR; PG8_WAIT_L(0); PG8_MMA(0, 0, At, B0); PG8_BAR; PG8_SCHED;
            PG8_LDB(B1, 1, 1); PG8_STAGE(PG8_SB(1, 0), b3, voffB);
            PG8_BAR; PG8_WAIT_L(0); PG8_MMA(0, 1, At, B1); PG8_BAR;
            PG8_LDA(At, 1, 1); PG8_STAGE(PG8_SA(1, 0), a3, voffA);
            PG8_BAR; PG8_WAIT_L(0); PG8_MMA(1, 0, At, B0); PG8_BAR; PG8_SCHED;
            PG8_STAGE(PG8_SB(1, 1), b3 + hstep, voffB);
            PG8_WAIT_V(6); PG8_BAR; PG8_MMA(1, 1, At, B1); PG8_BAR;
            }
        }
        if constexpr (ALIGN_EPI) { if (wr == 0) PG8_BAR; }
        if constexpr (!Epi::AFTER_DRAIN) { E(acc, cur, wr, wc, fr, fq); S.done(cur); }
        if (!has_next) break;
#pragma unroll
        for (int a = 0; a < 2; ++a)
#pragma unroll
            for (int b = 0; b < 2; ++b)
#pragma unroll
                for (int m = 0; m < 4; ++m)
#pragma unroll
                    for (int n = 0; n < 2; ++n) acc[a][b][m][n] = (f32x4){0.f, 0.f, 0.f, 0.f};
        cur = nxt; cA = nA; cB = nB; ++ui;
        if constexpr (ALIGN_EPI) { if (wr == 1) PG8_BAR; }
    }
    PG8_WAIT_V(0);
    if constexpr (!ALIGN_EPI) { if (wr == 0) PG8_BAR; }
    PG8_BAR;
    if constexpr (Epi::AFTER_DRAIN) { E.fused(acc, cur, wr, wc, fr, fq, lds, wid, lane); S.done(cur); }
#undef PG8_SA
#undef PG8_SB
#undef PG8_STAGE
#undef PG8_LDA
#undef PG8_LDB
#undef PG8_MMA
#undef PG8_WAIT_V
#undef PG8_WAIT_L
#undef PG8_BAR
#undef PG8_SCHED
}
}
typedef unsigned short bf16;
typedef short bf16x8 __attribute__((ext_vector_type(8)));
typedef float f32x4 __attribute__((ext_vector_type(4)));
typedef unsigned u32x4 __attribute__((ext_vector_type(4)));
typedef unsigned u32x2 __attribute__((ext_vector_type(2)));
#define LAS __attribute__((address_space(3)))
constexpr int M = 16384, D = 1024, FF = 2816, DIN = 3360, DINP = 3584, SEQ = 8192, NLAYER = 4, NPH = 13;
constexpr float ALPHA = 1.681792830507429f, EPS = 1e-5f;
constexpr int C_AU = 0, C_AV = 256, C_BQ = 512, C_BZ = 2048, C_BBETA = 2560, C_BDEC = 2568, C_CQ = 2576, C_CK = 2704, C_CV = 2832, C_CR = 3088, C_CG = 3344;
constexpr size_t MiB = 1u << 20;
constexpr size_t WS_CTL = 0, WS_W = 1 * MiB, WS_XB = 44 * MiB, WS_HP = 76 * MiB, WS_MIX = 188 * MiB;
constexpr size_t OW13A = 0, OW2A = 11534336, OWIN = 17301504, OWOUT = 24641536, OW13B = 26738688, OW2B = 38273024, OWM = 42 * MiB;
constexpr size_t WS_UBT = 220 * MiB, WS_WN = 236 * MiB, WS_KDT = 252 * MiB, WS_PF = 268 * MiB, WS_QD = 284 * MiB, WS_SP = 300 * MiB, WS_UF = 316 * MiB, WS_GTOT = 332 * MiB;
constexpr size_t WS_OIT = 333 * MiB, WS_QDG = 349 * MiB, WS_BNT = 353 * MiB, WS_ST = 361 * MiB, WS_GT = 365 * MiB, WS_END = 366 * MiB;
constexpr int LDS_BYTES = 133120;
#ifndef PH_HI
#define PH_HI (NLAYER * NPH)
#endif
#ifndef MIXSEL
#define MIXSEL 7
#endif
#ifndef ONE_LAUNCH
#define ONE_LAUNCH 1
#endif

__device__ __forceinline__ float bf2f(bf16 b) { return __uint_as_float((unsigned)b << 16); }
__device__ __forceinline__ float bflo(unsigned u) { return __uint_as_float(u << 16); }
__device__ __forceinline__ float bfhi(unsigned u) { return __uint_as_float(u & 0xffff0000u); }
typedef float f32x2_t __attribute__((ext_vector_type(2))); typedef __bf16 bf16x2_t __attribute__((ext_vector_type(2)));
__device__ __forceinline__ unsigned pk2(float lo, float hi) { f32x2_t v = {lo, hi}; bf16x2_t b = __builtin_convertvector(v, bf16x2_t); return __builtin_bit_cast(unsigned, b); }
__device__ __forceinline__ bf16 f2bf(float f) { return (bf16)(pk2(f, 0.f) & 0xffffu); }
__device__ __forceinline__ float sigm(float x) { return 1.0f / (1.0f + __expf(-x)); }
__device__ __forceinline__ float softplusf(float x) { return fmaxf(x, 0.f) + log1pf(__expf(-fabsf(x))); }
__device__ __forceinline__ bf16x8 mk8(u32x2 a, u32x2 b) { u32x4 v = {a.x, a.y, b.x, b.y}; return __builtin_bit_cast(bf16x8, v); }
__device__ __forceinline__ bf16x8 as8(u32x4 v) { return __builtin_bit_cast(bf16x8, v); }
__device__ __forceinline__ f32x4 mfma16(bf16x8 a, bf16x8 b, f32x4 c) { return __builtin_amdgcn_mfma_f32_16x16x32_bf16(a, b, c, 0, 0, 0); }
__device__ __forceinline__ float wave_sum(float v) {
#pragma unroll
    for (int o = 1; o < 64; o <<= 1) v += __shfl_xor(v, o);
    return v;
}

struct KArgs { const float* in[26]; float* out; unsigned char* ws; int lo, hi; };

__device__ __forceinline__ void tr_item(const float* W, int K, int N, bf16* WT, int mode, float* scr, int item, int lane) {
    const int nblk = N / 32, kb = item / nblk, nb = item - kb * nblk, k0 = 64 * kb, n0 = 32 * nb;
    const int drow = (mode == 0) ? n0 : ((n0 >> 7) * 256 + (n0 & 127) + (mode == 2 ? 128 : 0));
#pragma unroll 8
    for (int i = 0; i < 32; ++i) { const int kk = 2 * i + (lane >> 5); scr[kk * 33 + (lane & 31)] = W[(size_t)(k0 + kk) * N + n0 + (lane & 31)]; }
    asm volatile("s_waitcnt lgkmcnt(0)" ::: "memory");
    const int c = lane & 7;
#pragma unroll
    for (int j = 0; j < 4; ++j) { const int n = (lane >> 3) + 8 * j; const float* s = scr + (8 * c) * 33 + n;
        u32x4 o; o.x = pk2(s[0 * 33], s[1 * 33]); o.y = pk2(s[2 * 33], s[3 * 33]); o.z = pk2(s[4 * 33], s[5 * 33]); o.w = pk2(s[6 * 33], s[7 * 33]);
        *(u32x4*)(WT + (size_t)(drow + n) * K + k0 + 8 * c) = o; }
    asm volatile("s_waitcnt lgkmcnt(0)" ::: "memory");
}

__device__ __forceinline__ void phase_conv(const KArgs& a, int l, unsigned char* lds) {
    const int tid = opaque_tid(), lane = tid & 63, wave = tid >> 6;
    float* scr = (float*)(lds + wave * 8704);
    unsigned char* wb = a.ws + WS_W;
    const int gw = opaque_bid() * 8 + wave, NGW = gridDim.x * 8;
    constexpr int I_FF = 1408, I_IN = 1680, I_OUT = 512, NITEMS = 6 * I_FF + I_IN + I_OUT;
    for (int it = gw; it < NITEMS; it += NGW) {
        int r = it;
        if (r < I_FF) { tr_item(a.in[1] + (size_t)l * D * FF, D, FF, (bf16*)(wb + OW13A), 1, scr, r, lane); continue; } r -= I_FF;
        if (r < I_FF) { tr_item(a.in[2] + (size_t)l * D * FF, D, FF, (bf16*)(wb + OW13A), 2, scr, r, lane); continue; } r -= I_FF;
        if (r < I_FF) { tr_item(a.in[3] + (size_t)l * D * FF, FF, D, (bf16*)(wb + OW2A), 0, scr, r, lane); continue; } r -= I_FF;
        if (r < I_IN) { tr_item(a.in[6] + (size_t)l * D * DIN, D, DIN, (bf16*)(wb + OWIN), 0, scr, r, lane); continue; } r -= I_IN;
        if (r < I_OUT) { tr_item(a.in[18] + (size_t)l * D * D, D, D, (bf16*)(wb + OWOUT), 0, scr, r, lane); continue; } r -= I_OUT;
        if (r < I_FF) { tr_item(a.in[21] + (size_t)l * D * FF, D, FF, (bf16*)(wb + OW13B), 1, scr, r, lane); continue; } r -= I_FF;
        if (r < I_FF) { tr_item(a.in[22] + (size_t)l * D * FF, D, FF, (bf16*)(wb + OW13B), 2, scr, r, lane); continue; } r -= I_FF;
        tr_item(a.in[23] + (size_t)l * D * FF, FF, D, (bf16*)(wb + OW2B), 0, scr, r, lane);
    }
    const int gt = opaque_bid() * 512 + tid, NGT = gridDim.x * 512;
    { u32x4* p = (u32x4*)(wb + OWIN + (size_t)DIN * D * 2); const int n16 = (DINP - DIN) * D * 2 / 16;
      for (int i = gt; i < n16; i += NGT) p[i] = (u32x4){0u, 0u, 0u, 0u}; }
    { const float* sw = a.in[9] + (size_t)l * 65536; bf16* wm = (bf16*)(wb + OWM);
      for (int i = gt; i < 65536; i += NGT) { const int ii = (i >> 7) & 127, jj = i & 127; wm[i] = (jj <= ii) ? f2bf(sw[i]) : (bf16)0; } }
    if (l == 0) {
        const f32x4* xs = (const f32x4*)a.in[0]; f32x4* xo = (f32x4*)a.out; u32x2* xb = (u32x2*)(a.ws + WS_XB);
        for (int i = gt; i < M * D / 4; i += NGT) { const f32x4 v = xs[i]; xo[i] = v; xb[i] = (u32x2){pk2(v.x, v.y), pk2(v.z, v.w)}; }
    }
}

__device__ __forceinline__ void phase_ln(const KArgs& a, const float* g, const float* b) {
    const int tid = opaque_tid(), lane = tid & 63, wave = tid >> 6;
    const int gw = opaque_bid() * 8 + wave, NGW = gridDim.x * 8;
    f32x4 gv[4], bv[4];
#pragma unroll
    for (int j = 0; j < 4; ++j) { gv[j] = ((const f32x4*)g)[64 * j + lane]; bv[j] = ((const f32x4*)b)[64 * j + lane]; }
    for (int m = gw; m < M; m += NGW) {
        f32x4* xr = (f32x4*)(a.out + (size_t)m * D) + lane; u32x2* xb = (u32x2*)(a.ws + WS_XB + (size_t)m * D * 2) + lane;
        f32x4 v[4]; float s = 0.f;
#pragma unroll
        for (int j = 0; j < 4; ++j) { v[j] = xr[64 * j]; s += (v[j].x + v[j].y) + (v[j].z + v[j].w); }
        const float mean = wave_sum(s) * (1.f / D); float s2 = 0.f;
#pragma unroll
        for (int j = 0; j < 4; ++j) { v[j] = v[j] - mean; s2 += (v[j].x * v[j].x + v[j].y * v[j].y) + (v[j].z * v[j].z + v[j].w * v[j].w); }
        const float rstd = 1.f / sqrtf(wave_sum(s2) * (1.f / D) + EPS);
#pragma unroll
        for (int j = 0; j < 4; ++j) { const f32x4 y = v[j] * rstd * gv[j] + bv[j]; xr[64 * j] = y; xb[64 * j] = (u32x2){pk2(y.x, y.y), pk2(y.z, y.w)}; }
    }
}
__device__ __forceinline__ void m1_gdn(const KArgs& a, int l, int item, unsigned char* lds) {
    const int tid = opaque_tid(), lane = tid & 63, wave = tid >> 6, slot = wave >> 2, sw = wave & 3, tid4 = tid & 255;
    const int r = lane & 15, q = lane >> 4;
    const int unit = item * 2 + slot, b = unit >> 10, h = (unit >> 7) & 7, n = unit & 127;
    const int row0 = b * SEQ + n * 64;
    unsigned char* sl = lds + slot * 45056;
    bf16* qbf = (bf16*)sl; bf16* kbf = (bf16*)(sl + 9216); bf16* vbf = (bf16*)(sl + 18432);
    float* Lf = (float*)(sl + 27648); bf16* Wl = (bf16*)(sl + 27648);
    float* betaL = (float*)(sl + 44032); float* gamL = (float*)(sl + 44288);
    const bf16* HP = (const bf16*)(a.ws + WS_HP);
    const float* cw = a.in[11] + (size_t)l * 4 * 1536;
#pragma unroll 1
    for (int it = 0; it < 6; ++it) {
        const int e = it * 256 + tid4, tok = e / 24, g = e - tok * 24, ten = g >> 3, sub = g & 7;
        const int chh = ten * 512 + h * 64 + sub * 8;
        float y[8];
#pragma unroll
        for (int i = 0; i < 8; ++i) y[i] = 0.f;
#pragma unroll
        for (int tap = 0; tap < 4; ++tap) {
            const int tt = tok - 3 + tap;
            if (n * 64 + tt >= 0) {
                const u32x4 xv = *(const u32x4*)(HP + (size_t)(row0 + tt) * DINP + C_BQ + chh);
                const f32x4 w0 = *(const f32x4*)(cw + tap * 1536 + chh), w1 = *(const f32x4*)(cw + tap * 1536 + chh + 4);
                y[0] += w0.x * bflo(xv.x); y[1] += w0.y * bfhi(xv.x); y[2] += w0.z * bflo(xv.y); y[3] += w0.w * bfhi(xv.y);
                y[4] += w1.x * bflo(xv.z); y[5] += w1.y * bfhi(xv.z); y[6] += w1.z * bflo(xv.w); y[7] += w1.w * bfhi(xv.w);
            }
        }
        float ss = 0.f;
#pragma unroll
        for (int i = 0; i < 8; ++i) { y[i] = y[i] * sigm(y[i]); ss += y[i] * y[i]; }
        ss += __shfl_xor(ss, 1); ss += __shfl_xor(ss, 2); ss += __shfl_xor(ss, 4);
        const float inv = (ten == 2) ? 1.f : (rsqrtf(ss + 1e-6f) * (ten == 0 ? 0.125f : 1.f));
        u32x4 o; o.x = pk2(y[0] * inv, y[1] * inv); o.y = pk2(y[2] * inv, y[3] * inv); o.z = pk2(y[4] * inv, y[5] * inv); o.w = pk2(y[6] * inv, y[7] * inv);
        bf16* dst = (ten == 0 ? qbf : (ten == 1 ? kbf : vbf)) + tok * 72 + sub * 8;
        *(u32x4*)dst = o;
    }
    if (tid4 < 64) {
        const int tok = tid4;
        const float bl = bf2f(HP[(size_t)(row0 + tok) * DINP + C_BBETA + h]), dl = bf2f(HP[(size_t)(row0 + tok) * DINP + C_BDEC + h]);
        const float beta = sigm(bl);
        float lg = -expf(a.in[12][l * 8 + h]) * softplusf(dl + a.in[13][l * 8 + h]);
#pragma unroll
        for (int off = 1; off < 64; off <<= 1) { const float t = __shfl_up(lg, off); if (lane >= off) lg += t; }
        betaL[tok] = beta; gamL[tok] = lg;
    }
    __syncthreads();
    {
        const int it_ = sw;
        bf16x8 ka[2], qb[2];
#pragma unroll
        for (int ks = 0; ks < 2; ++ks) { ka[ks] = *(const bf16x8*)(kbf + (16 * it_ + r) * 72 + 32 * ks + 8 * q); qb[ks] = *(const bf16x8*)(qbf + (16 * it_ + r) * 72 + 32 * ks + 8 * q); }
        u32x2 pp[4];
#pragma unroll
        for (int jt = 0; jt < 4; ++jt) {
            pp[jt] = (u32x2){0u, 0u};
            if (jt <= it_) {
                bf16x8 kb[2];
#pragma unroll
                for (int ks = 0; ks < 2; ++ks) kb[ks] = *(const bf16x8*)(kbf + (16 * jt + r) * 72 + 32 * ks + 8 * q);
                f32x4 acc = {0.f, 0.f, 0.f, 0.f};
                acc = mfma16(ka[0], kb[0], acc); acc = mfma16(ka[1], kb[1], acc);
                { const int j = 16 * jt + r; const float gj = gamL[j];
#pragma unroll
                  for (int ii = 0; ii < 4; ++ii) { const int i = 16 * it_ + 4 * q + ii; Lf[i * 64 + j] = (j < i) ? betaL[i] * acc[ii] * __expf(gamL[i] - gj) : 0.f; } }
                f32x4 pc = {0.f, 0.f, 0.f, 0.f};
                pc = mfma16(kb[0], qb[0], pc); pc = mfma16(kb[1], qb[1], pc);
                { const int i = 16 * it_ + r; const float gi = gamL[i]; float pv[4];
#pragma unroll
                  for (int jj = 0; jj < 4; ++jj) { const int j = 16 * jt + 4 * q + jj; pv[jj] = (j <= i) ? pc[jj] * __expf(gi - gamL[j]) : 0.f; }
                  pp[jt] = (u32x2){pk2(pv[0], pv[1]), pk2(pv[2], pv[3])}; }
            }
        }
        u32x4* Pf = (u32x4*)(a.ws + WS_PF) + ((size_t)(unit * 4 + it_) * 2) * 64 + lane;
        Pf[0] = (u32x4){pp[0].x, pp[0].y, pp[1].x, pp[1].y};
        Pf[64] = (u32x4){pp[2].x, pp[2].y, pp[3].x, pp[3].y};
    }
    __syncthreads();
    float x[64];
    if (tid4 < 128) {
        const bool isk = tid4 >= 64; const int cc = tid4 & 63;
        const bf16* src = isk ? kbf : vbf;
#pragma unroll
        for (int i = 0; i < 64; ++i) {
            const float bi = betaL[i];
            float s = bf2f(src[i * 72 + cc]) * (isk ? bi * __expf(gamL[i]) : bi);
#pragma unroll
            for (int jj = 0; jj < (i + 3) / 4; ++jj) {
                const f32x4 Lr = *(const f32x4*)(Lf + i * 64 + 4 * jj);
#pragma unroll
                for (int e = 0; e < 4; ++e) if (4 * jj + e < i) s -= Lr[e] * x[4 * jj + e];
            }
            x[i] = s;
            asm volatile("" : "+v"(x[i]) :: "memory");
        }
    } else {
        const int t2 = tid4 - 128; const float glast = gamL[63];
        bf16* Qd = (bf16*)(a.ws + WS_QD) + (size_t)unit * 4096; bf16* KdT = (bf16*)(a.ws + WS_KDT) + (size_t)unit * 4096;
#pragma unroll 1
        for (int e = t2; e < 512; e += 128) { const int tok = e >> 3, sub = e & 7; const float sc = __expf(gamL[tok]);
            const u32x4 v = *(const u32x4*)(qbf + tok * 72 + sub * 8);
            u32x4 o; o.x = pk2(bflo(v.x) * sc, bfhi(v.x) * sc); o.y = pk2(bflo(v.y) * sc, bfhi(v.y) * sc); o.z = pk2(bflo(v.z) * sc, bfhi(v.z) * sc); o.w = pk2(bflo(v.w) * sc, bfhi(v.w) * sc);
            *(u32x4*)(Qd + tok * 64 + sub * 8) = o; }
#pragma unroll 1
        for (int e = t2; e < 512; e += 128) { const int dk = e & 63, tg = e >> 6; float v[8];
#pragma unroll
            for (int tt = 0; tt < 8; ++tt) { const int tok = tg * 8 + tt; v[tt] = bf2f(kbf[tok * 72 + dk]) * __expf(glast - gamL[tok]); }
            u32x4 o; o.x = pk2(v[0], v[1]); o.y = pk2(v[2], v[3]); o.z = pk2(v[4], v[5]); o.w = pk2(v[6], v[7]);
            *(u32x4*)(KdT + dk * 64 + tg * 8) = o; }
        if (t2 == 0) ((float*)(a.ws + WS_GTOT))[unit] = __expf(glast);
    }
    __syncthreads();
    if (tid4 < 64) {
        u32x4* ub = (u32x4*)((bf16*)(a.ws + WS_UBT) + (size_t)unit * 4096 + tid4 * 64);
#pragma unroll
        for (int g = 0; g < 8; ++g) ub[g] = (u32x4){pk2(x[8 * g], x[8 * g + 1]), pk2(x[8 * g + 2], x[8 * g + 3]), pk2(x[8 * g + 4], x[8 * g + 5]), pk2(x[8 * g + 6], x[8 * g + 7])};
    } else if (tid4 < 128) {
        const int cc = tid4 - 64;
#pragma unroll
        for (int i = 0; i < 64; ++i) Wl[i * 72 + cc] = f2bf(-x[i]);
    }
    __syncthreads();
    {
        bf16* Wn = (bf16*)(a.ws + WS_WN) + (size_t)unit * 4096;
#pragma unroll
        for (int e = tid4; e < 512; e += 256) { const int tok = e >> 3, sub = e & 7; *(u32x4*)(Wn + tok * 64 + sub * 8) = *(const u32x4*)(Wl + tok * 72 + sub * 8); }
    }
}

__device__ __forceinline__ void m1_sgu(const KArgs& a, int l, int unit, unsigned char* lds) {
    const int tid = opaque_tid(), lane = tid & 63, wave = tid >> 6, r = lane & 15, q = lane >> 4;
    const int b = unit >> 6, n = unit & 63, row0 = b * SEQ + n * 128;
    const bf16* HP = (const bf16*)(a.ws + WS_HP);
    bf16* vnT = (bf16*)lds;
    const float* lg = a.in[7] + l * 256; const float* lb = a.in[8] + l * 256;
    float gch[4], bch[4];
#pragma unroll
    for (int i = 0; i < 4; ++i) { gch[i] = lg[lane + 64 * i]; bch[i] = lb[lane + 64 * i]; }
#pragma unroll 4
    for (int tt = 0; tt < 16; ++tt) {
        const int tok = wave * 16 + tt; const bf16* src = HP + (size_t)(row0 + tok) * DINP + C_AV;
        float v[4]; float s = 0.f;
#pragma unroll
        for (int i = 0; i < 4; ++i) { v[i] = bf2f(src[lane + 64 * i]); s += v[i]; }
        const float mean = wave_sum(s) * (1.f / 256.f); float s2 = 0.f;
#pragma unroll
        for (int i = 0; i < 4; ++i) { v[i] -= mean; s2 += v[i] * v[i]; }
        const float rstd = rsqrtf(wave_sum(s2) * (1.f / 256.f) + EPS);
#pragma unroll
        for (int i = 0; i < 4; ++i) vnT[(lane + 64 * i) * 136 + tok] = f2bf(v[i] * rstd * gch[i] + bch[i]);
    }
    __syncthreads();
    const int h = wave >> 1, ih = wave & 1;
    const bf16* Wm = (const bf16*)(a.ws + WS_W + OWM) + h * 16384;
    f32x4 acc[4][4];
#pragma unroll
    for (int it = 0; it < 4; ++it)
#pragma unroll
        for (int dt = 0; dt < 4; ++dt) acc[it][dt] = (f32x4){0.f, 0.f, 0.f, 0.f};
#pragma unroll
    for (int ks = 0; ks < 4; ++ks) {
        if (32 * ks <= 64 * ih + 63) {
            bf16x8 av[4];
#pragma unroll
            for (int dt = 0; dt < 4; ++dt) av[dt] = *(const bf16x8*)(vnT + (h * 64 + 16 * dt + r) * 136 + 32 * ks + 8 * q);
#pragma unroll
            for (int it = 0; it < 4; ++it) {
                const bf16x8 bw = *(const bf16x8*)(Wm + (64 * ih + 16 * it + r) * 128 + 32 * ks + 8 * q);
#pragma unroll
                for (int dt = 0; dt < 4; ++dt) acc[it][dt] = mfma16(av[dt], bw, acc[it][dt]);
            }
        }
    }
    const float* sb = a.in[10] + (size_t)l * 512 + h * 128;
    bf16* MIX = (bf16*)(a.ws + WS_MIX);
#pragma unroll
    for (int it = 0; it < 4; ++it) {
        const int tok = 64 * ih + 16 * it + r; const float bias = sb[tok];
#pragma unroll
        for (int dt = 0; dt < 4; ++dt) {
            const int d0 = h * 64 + 16 * dt + 4 * q;
            const u32x2 uv = *(const u32x2*)(HP + (size_t)(row0 + tok) * DINP + C_AU + d0);
            f32x4 z = acc[it][dt]; if (!(MIXSEL & 1)) z = (f32x4){0.f, 0.f, 0.f, 0.f};
            *(u32x2*)(MIX + (size_t)(row0 + tok) * D + d0) = (u32x2){pk2(bflo(uv.x) * (z[0] + bias), bfhi(uv.x) * (z[1] + bias)), pk2(bflo(uv.y) * (z[2] + bias), bfhi(uv.y) * (z[3] + bias))};
        }
    }
}

__device__ __forceinline__ void m1_gla(const KArgs& a, int l, int item, unsigned char* lds) {
    const int tid = opaque_tid(), lane = tid & 63, wave = tid >> 6, r = lane & 15, q = lane >> 4;
    const int unit = item * 8 + wave, b = unit >> 9, h = (unit >> 7) & 3, n = unit & 127, row0 = b * SEQ + n * 64;
    unsigned char* wl = lds + wave * 14336;
    bf16* qdL = (bf16*)wl; bf16* knL = (bf16*)(wl + 5120);
    bf16* vT = (bf16*)wl; bf16* kdT = (bf16*)(wl + 9216);
    const bf16* HP = (const bf16*)(a.ws + WS_HP);
    const int dk = lane & 31, half = lane >> 5;
    float gu[16];
#pragma unroll
    for (int i = 0; i < 16; ++i) gu[i] = a.in[15][(size_t)l * 2048 + i * 128 + h * 32 + dk];
    const float gb = a.in[16][l * 128 + h * 32 + dk];
    float bc[32];
#pragma unroll
    for (int t = 0; t < 32; ++t) {
        const int tok = half * 32 + t; const u32x4* gp = (const u32x4*)(HP + (size_t)(row0 + tok) * DINP + C_CG);
        const u32x4 g0 = gp[0], g1 = gp[1];
        float dot = gb;
        dot += bflo(g0.x) * gu[0] + bfhi(g0.x) * gu[1] + bflo(g0.y) * gu[2] + bfhi(g0.y) * gu[3] + bflo(g0.z) * gu[4] + bfhi(g0.z) * gu[5] + bflo(g0.w) * gu[6] + bfhi(g0.w) * gu[7];
        dot += bflo(g1.x) * gu[8] + bfhi(g1.x) * gu[9] + bflo(g1.y) * gu[10] + bfhi(g1.y) * gu[11] + bflo(g1.z) * gu[12] + bfhi(g1.z) * gu[13] + bflo(g1.w) * gu[14] + bfhi(g1.w) * gu[15];
        const float la = -softplusf(-dot) * (1.f / 16.f);
        bc[t] = (t ? bc[t - 1] : 0.f) + la;
    }
    const float tot0 = __shfl(bc[31], dk);
    if (half) {
#pragma unroll
        for (int t = 0; t < 32; ++t) bc[t] += tot0;
    }
    const float blast = __shfl(bc[31], dk + 32);
    bf16* QdG = (bf16*)(a.ws + WS_QDG) + (size_t)unit * 2048;
    unsigned kdp[16];
#pragma unroll
    for (int t = 0; t < 32; t += 2) {
        float kd2[2];
#pragma unroll
        for (int u = 0; u < 2; ++u) {
            const int tok = half * 32 + t + u; const size_t ro = (size_t)(row0 + tok) * DINP;
            const float qv = bf2f(HP[ro + C_CQ + h * 32 + dk]), kv = bf2f(HP[ro + C_CK + h * 32 + dk]);
            const float bcv = bc[t + u];
            const bf16 qd = f2bf(qv * 0.17677669529663687f * __expf(bcv));
            qdL[tok * 40 + dk] = qd; QdG[tok * 32 + dk] = qd;
            knL[tok * 40 + dk] = f2bf(kv * __expf(-bcv));
            kd2[u] = kv * __expf(blast - bcv);
        }
        kdp[t >> 1] = pk2(kd2[0], kd2[1]);
    }
    if (half) ((float*)(a.ws + WS_GT))[unit * 32 + dk] = __expf(blast);
    asm volatile("s_waitcnt lgkmcnt(0)" ::: "memory");
    u32x2 pp[4][4];
#pragma unroll
    for (int it = 0; it < 4; ++it) {
        const bf16x8 qf = *(const bf16x8*)(qdL + (16 * it + r) * 40 + 8 * q);
#pragma unroll
        for (int jt = 0; jt < 4; ++jt) {
            pp[it][jt] = (u32x2){0u, 0u};
            if (jt <= it) {
                const bf16x8 kf = *(const bf16x8*)(knL + (16 * jt + r) * 40 + 8 * q);
                f32x4 pc = {0.f, 0.f, 0.f, 0.f};
                pc = mfma16(kf, qf, pc);
                const int i = 16 * it + r; float pv[4];
#pragma unroll
                for (int jj = 0; jj < 4; ++jj) { const int j = 16 * jt + 4 * q + jj; pv[jj] = (j <= i) ? pc[jj] : 0.f; }
                pp[it][jt] = (u32x2){pk2(pv[0], pv[1]), pk2(pv[2], pv[3])};
            }
        }
    }
    asm volatile("s_waitcnt lgkmcnt(0)" ::: "memory");
#pragma unroll
    for (int t = 0; t < 32; t += 2) { const int tok = half * 32 + t; *(unsigned*)(kdT + dk * 72 + tok) = kdp[t >> 1]; }
#pragma unroll 2
    for (int it = 0; it < 8; ++it) {
        const int e = it * 64 + lane, tok = e >> 3, g = e & 7;
        const u32x4 v = *(const u32x4*)(HP + (size_t)(row0 + tok) * DINP + C_CV + h * 64 + g * 8);
        bf16* d = vT + (g * 8) * 72 + tok;
        d[0] = (bf16)(v.x & 0xffffu); d[72] = (bf16)(v.x >> 16); d[144] = (bf16)(v.y & 0xffffu); d[216] = (bf16)(v.y >> 16);
        d[288] = (bf16)(v.z & 0xffffu); d[360] = (bf16)(v.z >> 16); d[432] = (bf16)(v.w & 0xffffu); d[504] = (bf16)(v.w >> 16);
    }
    asm volatile("s_waitcnt lgkmcnt(0)" ::: "memory");
    f32x4* OiT = (f32x4*)(a.ws + WS_OIT) + (size_t)unit * 1024 + lane;
#pragma unroll
    for (int dt = 0; dt < 4; ++dt) {
        bf16x8 va[2];
#pragma unroll
        for (int ks = 0; ks < 2; ++ks) va[ks] = mk8(*(const u32x2*)(vT + (16 * dt + r) * 72 + 32 * ks + 4 * q), *(const u32x2*)(vT + (16 * dt + r) * 72 + 32 * ks + 16 + 4 * q));
#pragma unroll
        for (int it = 0; it < 4; ++it) {
            f32x4 acc = {0.f, 0.f, 0.f, 0.f};
            acc = mfma16(va[0], mk8(pp[it][0], pp[it][1]), acc);
            if (it >= 2) acc = mfma16(va[1], mk8(pp[it][2], pp[it][3]), acc);
            OiT[(it * 4 + dt) * 64] = acc;
        }
    }
    float* BnT = (float*)(a.ws + WS_BNT) + (size_t)unit * 2048;
#pragma unroll
    for (int dt = 0; dt < 4; ++dt) {
        bf16x8 va[2];
#pragma unroll
        for (int ks = 0; ks < 2; ++ks) va[ks] = *(const bf16x8*)(vT + (16 * dt + r) * 72 + 32 * ks + 8 * q);
#pragma unroll
        for (int kt = 0; kt < 2; ++kt) {
            f32x4 acc = {0.f, 0.f, 0.f, 0.f};
#pragma unroll
            for (int ks = 0; ks < 2; ++ks) acc = mfma16(va[ks], *(const bf16x8*)(kdT + (16 * kt + r) * 72 + 32 * ks + 8 * q), acc);
#pragma unroll
            for (int i = 0; i < 4; ++i) BnT[(16 * dt + 4 * q + i) * 32 + 16 * kt + r] = acc[i];
        }
    }
}

__device__ __forceinline__ void phase_m1(const KArgs& a, int l, unsigned char* lds) {
    for (int item = opaque_bid(); item < 1280; item += gridDim.x) {
        __syncthreads();
        if (item < 1024) m1_gdn(a, l, item, lds);
        else if (item < 1152) m1_sgu(a, l, item - 1024, lds);
        else m1_gla(a, l, item - 1152, lds);
    }
}
__device__ __forceinline__ void phase_m2(const KArgs& a) {
    const int tid = opaque_tid(), lane = tid & 63, wave = tid >> 6, r = lane & 15, q = lane >> 4;
    const int blk = opaque_bid();
    if (blk < 64) {
        if (wave != 0) return;
        const int b = blk >> 5, h = (blk >> 2) & 7, s = blk & 3;
        const int u0 = (b * 8 + h) * 128;
        const bf16* Wn = (const bf16*)(a.ws + WS_WN); const bf16* KdT = (const bf16*)(a.ws + WS_KDT); const bf16* ubT = (const bf16*)(a.ws + WS_UBT);
        const float* Gtot = (const float*)(a.ws + WS_GTOT);
        u32x4* SP = (u32x4*)(a.ws + WS_SP); u32x4* UF = (u32x4*)(a.ws + WS_UF);
        f32x4 S[4];
#pragma unroll
        for (int mt = 0; mt < 4; ++mt) S[mt] = (f32x4){0.f, 0.f, 0.f, 0.f};
        u32x2 wlo[4][2], whi[4][2], klo[4][2], khi[4][2], ubv[4]; float g;
#define M2_LOAD(uidx) do { const bf16* wp = Wn + (size_t)(uidx) * 4096; const bf16* kp = KdT + (size_t)(uidx) * 4096; const bf16* up = ubT + (size_t)(uidx) * 4096; \
        _Pragma("unroll") for (int t = 0; t < 4; ++t) { _Pragma("unroll") for (int ks = 0; ks < 2; ++ks) { \
            wlo[t][ks] = *(const u32x2*)(wp + (16 * t + r) * 64 + 32 * ks + 4 * q); whi[t][ks] = *(const u32x2*)(wp + (16 * t + r) * 64 + 32 * ks + 16 + 4 * q); \
            klo[t][ks] = *(const u32x2*)(kp + (16 * t + r) * 64 + 32 * ks + 4 * q); khi[t][ks] = *(const u32x2*)(kp + (16 * t + r) * 64 + 32 * ks + 16 + 4 * q); } \
            ubv[t] = *(const u32x2*)(up + (16 * s + r) * 64 + 16 * t + 4 * q); } \
        g = Gtot[uidx]; } while (0)
        M2_LOAD(u0);
#pragma unroll 1
        for (int n = 0; n < 128; ++n) {
            const int uidx = u0 + n;
            bf16x8 wa[4][2], ka[4][2]; f32x4 u[4]; const float gc = g;
#pragma unroll
            for (int t = 0; t < 4; ++t) {
#pragma unroll
                for (int ks = 0; ks < 2; ++ks) { wa[t][ks] = mk8(wlo[t][ks], whi[t][ks]); ka[t][ks] = mk8(klo[t][ks], khi[t][ks]); }
                u[t] = (f32x4){bflo(ubv[t].x), bfhi(ubv[t].x), bflo(ubv[t].y), bfhi(ubv[t].y)};
            }
            if (n + 1 < 128) M2_LOAD(uidx + 1);
            u32x4 sb[2];
#pragma unroll
            for (int ks = 0; ks < 2; ++ks) sb[ks] = (u32x4){pk2(S[2 * ks][0], S[2 * ks][1]), pk2(S[2 * ks][2], S[2 * ks][3]), pk2(S[2 * ks + 1][0], S[2 * ks + 1][1]), pk2(S[2 * ks + 1][2], S[2 * ks + 1][3])};
            SP[((size_t)(uidx * 4 + s) * 2 + 0) * 64 + lane] = sb[0]; SP[((size_t)(uidx * 4 + s) * 2 + 1) * 64 + lane] = sb[1];
#pragma unroll
            for (int ks = 0; ks < 2; ++ks)
#pragma unroll
                for (int t = 0; t < 4; ++t) u[t] = mfma16(wa[t][ks], as8(sb[ks]), u[t]);
            u32x4 up2[2];
#pragma unroll
            for (int ks = 0; ks < 2; ++ks) up2[ks] = (u32x4){pk2(u[2 * ks][0], u[2 * ks][1]), pk2(u[2 * ks][2], u[2 * ks][3]), pk2(u[2 * ks + 1][0], u[2 * ks + 1][1]), pk2(u[2 * ks + 1][2], u[2 * ks + 1][3])};
            UF[((size_t)(uidx * 4 + s) * 2 + 0) * 64 + lane] = up2[0]; UF[((size_t)(uidx * 4 + s) * 2 + 1) * 64 + lane] = up2[1];
#pragma unroll
            for (int t = 0; t < 4; ++t) S[t] = S[t] * gc;
#pragma unroll
            for (int ks = 0; ks < 2; ++ks)
#pragma unroll
                for (int t = 0; t < 4; ++t) S[t] = mfma16(ka[t][ks], as8(up2[ks]), S[t]);
        }
#undef M2_LOAD
    } else if (blk < 96) {
        const int gid = (blk - 64) * 512 + tid, bh = gid >> 11, rem = gid & 2047;
        const int dk = rem & 31;
        const float* BnT = (const float*)(a.ws + WS_BNT) + (size_t)bh * 128 * 2048 + rem;
        const float* Gt = (const float*)(a.ws + WS_GT) + (size_t)bh * 128 * 32 + dk;
        bf16* ST = (bf16*)(a.ws + WS_ST) + (size_t)bh * 128 * 2048 + rem;
        float S = 0.f;
#pragma unroll 1
        for (int n0 = 0; n0 < 128; n0 += 8) {
            float bn[8], gt[8];
#pragma unroll
            for (int i = 0; i < 8; ++i) { bn[i] = BnT[(size_t)(n0 + i) * 2048]; gt[i] = Gt[(n0 + i) * 32]; }
#pragma unroll
            for (int i = 0; i < 8; ++i) { ST[(size_t)(n0 + i) * 2048] = f2bf(S); S = gt[i] * S + bn[i]; }
        }
    }
}

__device__ __forceinline__ void phase_m3(const KArgs& a, int l) {
    const int tid = opaque_tid(), lane = tid & 63, wave = tid >> 6, r = lane & 15, q = lane >> 4;
    const int gw = opaque_bid() * 8 + wave, NGW = gridDim.x * 8;
    const bf16* HP = (const bf16*)(a.ws + WS_HP); bf16* MIX = (bf16*)(a.ws + WS_MIX);
#pragma unroll 1
    for (int wi = gw; wi < 12288; wi += NGW) {
        f32x4 acc[4]; int row, zc, oc; const float* ng;
        if (wi < 8192) {
            const int unit = wi >> 2, it = wi & 3, b = unit >> 10, h = (unit >> 7) & 7, n = unit & 127;
            const bf16* Qd = (const bf16*)(a.ws + WS_QD) + (size_t)unit * 4096 + (16 * it + r) * 64;
            bf16x8 qa[2], pa[2];
#pragma unroll
            for (int ks = 0; ks < 2; ++ks) { qa[ks] = mk8(*(const u32x2*)(Qd + 32 * ks + 4 * q), *(const u32x2*)(Qd + 32 * ks + 16 + 4 * q));
                pa[ks] = as8(((const u32x4*)(a.ws + WS_PF))[((size_t)(unit * 4 + it) * 2 + ks) * 64 + lane]); }
#pragma unroll
            for (int dt = 0; dt < 4; ++dt) {
                f32x4 c = {0.f, 0.f, 0.f, 0.f};
#pragma unroll
                for (int ks = 0; ks < 2; ++ks) {
                    const bf16x8 sf = as8(((const u32x4*)(a.ws + WS_SP))[((size_t)(unit * 4 + dt) * 2 + ks) * 64 + lane]);
                    const bf16x8 uf = as8(((const u32x4*)(a.ws + WS_UF))[((size_t)(unit * 4 + dt) * 2 + ks) * 64 + lane]);
                    c = mfma16(sf, qa[ks], c); c = mfma16(uf, pa[ks], c);
                }
                acc[dt] = c;
            }
            row = b * SEQ + n * 64 + 16 * it + r; zc = C_BZ + h * 64; oc = 256 + h * 64; ng = a.in[14] + l * 64;
        } else {
            const int w2 = wi - 8192, unit = w2 >> 2, it = w2 & 3, b = unit >> 9, h = (unit >> 7) & 3, n = unit & 127;
            const bf16x8 qa = *(const bf16x8*)((const bf16*)(a.ws + WS_QDG) + (size_t)unit * 2048 + (16 * it + r) * 32 + 8 * q);
            const f32x4* OiT = (const f32x4*)(a.ws + WS_OIT) + (size_t)unit * 1024 + lane;
            const bf16* ST = (const bf16*)(a.ws + WS_ST) + (size_t)unit * 2048;
#pragma unroll
            for (int dt = 0; dt < 4; ++dt) {
                const bf16x8 sa = *(const bf16x8*)(ST + (16 * dt + r) * 32 + 8 * q);
#if GLA_DBG == 1
                acc[dt] = OiT[(it * 4 + dt) * 64];
#elif GLA_DBG == 2
                acc[dt] = mfma16(sa, qa, (f32x4){0.f, 0.f, 0.f, 0.f});
#else
                acc[dt] = mfma16(sa, qa, OiT[(it * 4 + dt) * 64]);
#endif
            }
            row = b * SEQ + n * 64 + 16 * it + r; zc = C_CR + h * 64; oc = 768 + h * 64; ng = a.in[17] + l * 64;
        }
        if ((wi < 8192) ? !(MIXSEL & 2) : !(MIXSEL & 4)) { for (int dt = 0; dt < 4; ++dt) acc[dt] = (f32x4){0.f, 0.f, 0.f, 0.f}; }
        float ss = 0.f;
#pragma unroll
        for (int dt = 0; dt < 4; ++dt) ss += (acc[dt][0] * acc[dt][0] + acc[dt][1] * acc[dt][1]) + (acc[dt][2] * acc[dt][2] + acc[dt][3] * acc[dt][3]);
        ss += __shfl_xor(ss, 16); ss += __shfl_xor(ss, 32);
        const float rs = rsqrtf(ss * (1.f / 64.f) + EPS);
#pragma unroll
        for (int dt = 0; dt < 4; ++dt) {
            const int d0 = 16 * dt + 4 * q;
            const u32x2 zv = *(const u32x2*)(HP + (size_t)row * DINP + zc + d0);
            const f32x4 gn = *(const f32x4*)(ng + d0);
            const float z0 = bflo(zv.x), z1 = bfhi(zv.x), z2 = bflo(zv.y), z3 = bfhi(zv.y);
            const float o0 = acc[dt][0] * rs * gn.x * z0 * sigm(z0), o1 = acc[dt][1] * rs * gn.y * z1 * sigm(z1), o2 = acc[dt][2] * rs * gn.z * z2 * sigm(z2), o3 = acc[dt][3] * rs * gn.w * z3 * sigm(z3);
            *(u32x2*)(MIX + (size_t)row * D + oc + d0) = (u32x2){pk2(o0, o1), pk2(o2, o3)};
        }
    }
}

typedef unsigned gu32;
#define XB_TMO      128
#define XB_XCNT(j)  (256  + 64 * (j))
#define XB_XSUB(j)  (1280 + 64 * (j))
#define XB_XGEN(j)  (2304 + 64 * (j))
#define XB_TOP      3328
#define XB_TOPGEN   3392
#define XCD_BAR_WORDS 3456
#define XB_SPIN_CAP (1u << 18)

__device__ __forceinline__ unsigned xb_ld(unsigned* p)              { return __hip_atomic_load(p, __ATOMIC_RELAXED, __HIP_MEMORY_SCOPE_AGENT); }
__device__ __forceinline__ unsigned xb_add(unsigned* p, unsigned v) { return __hip_atomic_fetch_add(p, v, __ATOMIC_RELAXED, __HIP_MEMORY_SCOPE_AGENT); }
__device__ __forceinline__ unsigned xb_xcc_id() { return (unsigned)__builtin_amdgcn_s_getreg((3 << 11) | 20) & 0xFu; }
#define XB_SPIN(cond, bar) do { unsigned _sp = 0; while (cond) { __builtin_amdgcn_s_sleep(1); \
    if ((++_sp & 255u) == 0u) { if (xb_ld(&(bar)[XB_TMO])) break; if (_sp > XB_SPIN_CAP) { atomicAdd(&(bar)[XB_TMO], 1u); break; } } } } while (0)

struct XcdBarrier {
    unsigned* bar; unsigned x;
    volatile LAS unsigned* st;
};

__device__ __forceinline__ XcdBarrier xcd_barrier_post(unsigned* bar, volatile LAS unsigned* st) {
    XcdBarrier b; b.bar = bar; b.x = xb_xcc_id(); b.st = st;
    if (threadIdx.x == 0) (void)xb_add(&bar[XB_XCNT(b.x)], 1u);
    return b;
}
__device__ __forceinline__ void xcd_barrier_complete(unsigned* bar, unsigned x, unsigned& nloc, unsigned& nx) {
    const unsigned G = gridDim.x * gridDim.y * gridDim.z;
    unsigned sum, cnt, mine, sp = 0u;
    for (;;) {
        sum = 0u; cnt = 0u; mine = 0u;
#pragma unroll
        for (unsigned j = 0; j < 16; ++j) { const unsigned c = xb_ld(&bar[XB_XCNT(j)]); sum += c; cnt += (c > 0u) ? 1u : 0u; mine = (j == x) ? c : mine; }
        if (sum == G) break;
        __builtin_amdgcn_s_sleep(1);
        if ((++sp & 255u) == 0u) { if (xb_ld(&bar[XB_TMO])) break; if (sp > XB_SPIN_CAP) { atomicAdd(&bar[XB_TMO], 1u); break; } }
    }
    nloc = mine > 0u ? mine : 1u; nx = cnt > 0u ? cnt : 1u;
}

__device__ __forceinline__ void xcd_barrier(const XcdBarrier& b) {
    asm volatile("s_waitcnt vmcnt(0)" ::: "memory");
    __syncthreads();
    if (threadIdx.x == 0) {
        unsigned* bar = b.bar;
        __builtin_amdgcn_s_waitcnt(0);
        unsigned nloc = b.st[0], nx = b.st[1];
        if (nloc == 0u) { xcd_barrier_complete(bar, b.x, nloc, nx); b.st[0] = nloc; b.st[1] = nx; }
        const unsigned old = xb_add(&bar[XB_XSUB(b.x)], 1u);
        const unsigned gen = old / nloc;
        if (old + 1u == (gen + 1u) * nloc) {
            __builtin_amdgcn_fence(__ATOMIC_RELEASE, "agent");
            asm volatile("s_waitcnt vmcnt(0)" ::: "memory");
            const unsigned og = xb_add(&bar[XB_TOP], 1u);
            const unsigned tg = og / nx;
            if (og + 1u == (tg + 1u) * nx) xb_add(&bar[XB_TOPGEN], 1u);
            else XB_SPIN(xb_ld(&bar[XB_TOPGEN]) == tg, bar);
            __builtin_amdgcn_fence(__ATOMIC_ACQUIRE, "agent");
            xb_add(&bar[XB_XGEN(b.x)], 1u);
            asm volatile("s_waitcnt vmcnt(0)" ::: "memory");
        } else {
            XB_SPIN(xb_ld(&bar[XB_XGEN(b.x)]) == gen, bar);
            __builtin_amdgcn_fence(__ATOMIC_ACQUIRE, "agent");
            asm volatile("s_waitcnt vmcnt(0)" ::: "memory");
        }
    }
    __syncthreads();
}

__global__ void __launch_bounds__(512, 2) mk_fwd(KArgs a) {
    extern __shared__ __attribute__((aligned(16))) unsigned char lds[];
    cg::grid_group grid = cg::this_grid();
    volatile LAS unsigned* MISC = (volatile LAS unsigned*)((LAS unsigned char*)lds + 131072);
    if (threadIdx.x < 16) MISC[threadIdx.x] = 0u;
    __syncthreads();
    XcdBarrier bar = xcd_barrier_post((unsigned*)(a.ws + WS_CTL) + 4096, MISC + 8);
    for (int ph = a.lo; ph < a.hi; ++ph) {
        const int l = ph / NPH, k = ph - l * NPH;
        unsigned char* ws = a.ws; asm volatile("" : "+s"(ws));
        const bf16* XB = (const bf16*)(ws + WS_XB); bf16* HB = (bf16*)(ws + WS_HP);
        if (k == 0) phase_conv(a, l, lds);
        else if (k == 1 || k == 10) {
            pg8::Gemm g{XB, (const bf16*)(ws + WS_W + (k == 1 ? OW13A : OW13B)), M, 2 * FF, D}; pg8::StaticOrder S; S.init(M, 2 * FF, gridDim.x, opaque_bid());
            pg8::EpiSwiglu E{HB, FF};
            pg8::gemm_phase<pg8::EpiSwiglu, pg8::StaticOrder, true, true>((LAS unsigned char*)lds, g, S, E);
        } else if (k == 2 || k == 11 || k == 8) {
            pg8::Gemm g; pg8::EpiRes E{a.out, D, ALPHA, 0.5f};
            if (k == 8) { g = pg8::Gemm{(const bf16*)(ws + WS_MIX), (const bf16*)(ws + WS_W + OWOUT), M, D, D}; E.cs = 1.0f; }
            else g = pg8::Gemm{HB, (const bf16*)(ws + WS_W + (k == 2 ? OW2A : OW2B)), M, D, FF};
            pg8::StaticOrder S; S.init(M, D, gridDim.x, opaque_bid());
            pg8::gemm_phase<pg8::EpiRes, pg8::StaticOrder, true, true>((LAS unsigned char*)lds, g, S, E);
        } else if (k == 3 || k == 9 || k == 12) {
            const int gi = (k == 3) ? 4 : (k == 9 ? 19 : 24);
            phase_ln(a, a.in[gi] + l * D, a.in[gi + 1] + l * D);
        } else if (k == 4) {
            pg8::Gemm g{XB, (const bf16*)(ws + WS_W + OWIN), M, DINP, D}; pg8::StaticOrder S; S.init(M, DINP, gridDim.x, opaque_bid());
            pg8::EpiProj E{HB, DINP, 2};
            pg8::gemm_phase<pg8::EpiProj, pg8::StaticOrder, true, true>((LAS unsigned char*)lds, g, S, E);
        } else if (k == 5) phase_m1(a, l, lds);
        else if (k == 6) phase_m2(a);
        else phase_m3(a, l);
        if (ph + 1 < a.hi) { if (ph == a.lo) grid.sync(); else xcd_barrier(bar); }
    }
}

extern "C" void kernel_launch(void* const* d_in, const int* in_sizes, int n_in, void* d_out, int out_size, void* d_ws, size_t ws_size, hipStream_t stream) {
    static int grid = 0;
    if (grid == 0) {
        if (n_in != 26 || out_size != M * D || ws_size < WS_END) { fprintf(stderr, "kernel_launch: unexpected sizes n_in %d out %d ws %zu\n", n_in, out_size, ws_size); grid = -1; return; }
        int dev = 0, cus = 0;
        if (hipGetDevice(&dev) != hipSuccess || hipDeviceGetAttribute(&cus, hipDeviceAttributeMultiprocessorCount, dev) != hipSuccess) { grid = -1; return; }
        if (hipFuncSetAttribute((const void*)mk_fwd, hipFuncAttributeMaxDynamicSharedMemorySize, LDS_BYTES) != hipSuccess) { fprintf(stderr, "kernel_launch: hipFuncSetAttribute failed\n"); grid = -1; return; }
        grid = cus;
    }
    if (grid < 0) return;
    if (hipMemsetAsync((char*)d_ws + WS_CTL, 0, 1u << 20, stream) != hipSuccess) return;
    KArgs a{};
    for (int i = 0; i < 26; ++i) a.in[i] = (const float*)d_in[i];
    a.out = (float*)d_out; a.ws = (unsigned char*)d_ws;
#if ONE_LAUNCH
    a.lo = 0; a.hi = PH_HI;
    void* args[] = {&a};
    hipError_t e = hipLaunchCooperativeKernel((const void*)mk_fwd, dim3(grid), dim3(512), args, LDS_BYTES, stream);
    if (e != hipSuccess) fprintf(stderr, "cooperative launch failed: %s\n", hipGetErrorString(e));
#else
    for (int ph = 0; ph < PH_HI; ++ph) { a.lo = ph; a.hi = ph + 1; hipLaunchKernelGGL(mk_fwd, dim3(grid), dim3(512), LDS_BYTES, stream, a); }
#endif
}
```

```cpp
#include <hip/hip_runtime.h>
#define GLA_DBG 0
#include <hip/hip_cooperative_groups.h>
#include <cstdio>
#include <cstdint>
namespace cg = cooperative_groups;
__device__ __forceinline__ int opaque_tid() { int t = threadIdx.x; asm volatile("" : "+v"(t)); return t; }
__device__ __forceinline__ int opaque_bid() { int b = blockIdx.x; asm volatile("" : "+s"(b)); return b; }
namespace pg8 {
#define PG8_LAS __attribute__((address_space(3)))
typedef unsigned short bf16_t;
typedef short bf16x8 __attribute__((ext_vector_type(8)));
typedef float f32x4 __attribute__((ext_vector_type(4)));
typedef unsigned u32x4 __attribute__((ext_vector_type(4)));
constexpr int BM = 256, BK = 64, HALF = 128, HTB = HALF * BK * 2  , STAGE_BYTES = 8 * HTB, NXCD = 8, WGM = 8;

__host__ __device__ __forceinline__ int lds_byte(int r, int c) { const int st = (r >> 4) * 2 + (c >> 5), rr = r & 15, cc = c & 31, ob = rr * 64 + cc * 2; return st * 1024 + (ob ^ (((ob >> 9) & 1) << 5)); }
__host__ __device__ __forceinline__ void stage_rc(int b, int& R, int& C) { const int st = b / 1024, sb = b % 1024, swz = sb ^ (((sb >> 9) & 1) << 5); R = (st >> 1) * 16 + swz / 64; C = (st & 1) * 32 + (swz % 64) / 2; }
__host__ __device__ __forceinline__ int perm32(int rho) { const int n = rho >> 4, i = rho & 15; return 8 * (i >> 2) + 4 * n + (i & 3); }

struct Unit { int pm, pn; };
struct Gemm { const bf16_t* A; const bf16_t* Bt; int M, N, K; };

struct StaticOrder {
    int nM, nN, nwg, G, c;
    __host__ __device__ void init(int M, int N, int G_, int c_) { nM = M / BM; nN = N / BM; nwg = nM * nN; G = G_; c = c_; }
    __host__ __device__ bool next(int i, Unit& u) const {
        const long L = (long)i * G + c; if (L >= nwg) return false;
        int wgid = (int)L; { const int q = nwg / NXCD, r = nwg % NXCD, xcd = wgid % NXCD, off = wgid / NXCD; wgid = (xcd < r ? xcd * (q + 1) : r * (q + 1) + (xcd - r) * q) + off; }
        const int nig = WGM * nN, gid = wgid / nig, fm = gid * WGM, gsz = (nM - fm) < WGM ? (nM - fm) : WGM;
        u.pm = fm + ((wgid % nig) % gsz); u.pn = (wgid % nig) / gsz; return true;
    }
    __device__ __forceinline__ void a_ready(const Unit&) const {}
    __device__ __forceinline__ void done(const Unit&) const {}
};

__device__ __forceinline__ unsigned cvt_pk_bf16(float lo, float hi) { unsigned r; asm volatile("v_cvt_pk_bf16_f32 %0, %1, %2" : "=v"(r) : "v"(lo), "v"(hi)); return r; }
typedef float f32x2 __attribute__((ext_vector_type(2)));
__device__ __forceinline__ f32x2 gelu_pk(f32x2 v) {
    const f32x2 av = __builtin_elementwise_abs(v), d = av * 0.2316418882f + 1.0f;
    f32x2 t; t.x = __builtin_amdgcn_rcpf(d.x); t.y = __builtin_amdgcn_rcpf(d.y);
    f32x2 q = t * 0.5307027145f + (-0.7265760135f); q = q * t + 0.7107068705f; q = q * t + (-0.142248368f); q = q * t + 0.127414796f; q = q * t;
    const f32x2 s = (v * v) * (-0.72134752044f);
    f32x2 e; e.x = __builtin_amdgcn_exp2f(s.x); e.y = __builtin_amdgcn_exp2f(s.y);
    const f32x2 m = v * (q * e), r = v - m;
    f32x2 o; o.x = v.x < 0.f ? m.x : r.x; o.y = v.y < 0.f ? m.y : r.y; return o;
}

template <int ACT  > struct EpiBf16 {
    static constexpr bool PERM = true, AFTER_DRAIN = false; static_assert(ACT == 0 || ACT == 1, "EpiBf16: ACT is 0 (none) or 1 (gelu_pk)");
    bf16_t* O; int ldc; const float* bias; int split_cols; size_t split_stride; float scale0;
    __device__ __forceinline__ void operator()(const f32x4 (&acc)[2][2][4][2], const Unit& u, int wr, int wc, int fr, int fq) const {
        const int row0 = u.pm * BM + wr * 64 + fr; int colt = u.pn * BM; bf16_t* base = O;
        float sc = 1.f; if (split_cols) { const int t = colt / split_cols; base += (size_t)t * split_stride; colt -= t * split_cols; if (t == 0) sc = scale0; }
        const int col0 = colt + wc * 32 + 8 * fq, bcol0 = u.pn * BM + wc * 32 + 8 * fq;
        f32x4 bv[2][2];
#pragma unroll
        for (int bj = 0; bj < 2; ++bj)
#pragma unroll
            for (int n = 0; n < 2; ++n) bv[bj][n] = bias ? *(const f32x4*)(bias + bcol0 + bj * HALF + 4 * n) : (f32x4){0.f, 0.f, 0.f, 0.f};
#pragma unroll
        for (int ai = 0; ai < 2; ++ai)
#pragma unroll
            for (int m = 0; m < 4; ++m) { bf16_t* rowp = base + (size_t)(row0 + ai * HALF + m * 16) * ldc + col0;
#pragma unroll
                for (int bj = 0; bj < 2; ++bj) { f32x4 v0 = acc[ai][bj][m][0] + bv[bj][0], v1 = acc[ai][bj][m][1] + bv[bj][1];
                    if (ACT == 1) { f32x2 a = gelu_pk((f32x2){v0[0], v0[1]}), b = gelu_pk((f32x2){v0[2], v0[3]}), c = gelu_pk((f32x2){v1[0], v1[1]}), d = gelu_pk((f32x2){v1[2], v1[3]});
                        v0 = (f32x4){a.x, a.y, b.x, b.y}; v1 = (f32x4){c.x, c.y, d.x, d.y}; }
                    v0 = v0 * sc; v1 = v1 * sc; u32x4 w; w.x = cvt_pk_bf16(v0[0], v0[1]); w.y = cvt_pk_bf16(v0[2], v0[3]); w.z = cvt_pk_bf16(v1[0], v1[1]); w.w = cvt_pk_bf16(v1[2], v1[3]);
                    *(u32x4*)(rowp + bj * HALF) = w; } }
    }
};
__device__ __forceinline__ float fast_sigmoid(float x) { return __builtin_amdgcn_rcpf(1.0f + __expf(-x)); }
struct EpiSwiglu {
    static constexpr bool PERM = true, AFTER_DRAIN = false;
    bf16_t* O; int ldc;
    __device__ __forceinline__ void operator()(const f32x4 (&acc)[2][2][4][2], const Unit& u, int wr, int wc, int fr, int fq) const {
        const int row0 = u.pm * BM + wr * 64 + fr; const int col0 = u.pn * HALF + wc * 32 + 8 * fq;
#pragma unroll
        for (int ai = 0; ai < 2; ++ai)
#pragma unroll
            for (int m = 0; m < 4; ++m) { bf16_t* rowp = O + (size_t)(row0 + ai * HALF + m * 16) * ldc + col0;
                float h[8];
#pragma unroll
                for (int n = 0; n < 2; ++n)
#pragma unroll
                    for (int i = 0; i < 4; ++i) { const float g = acc[ai][0][m][n][i], up = acc[ai][1][m][n][i]; h[n * 4 + i] = g * fast_sigmoid(g) * up; }
                u32x4 w; w.x = cvt_pk_bf16(h[0], h[1]); w.y = cvt_pk_bf16(h[2], h[3]); w.z = cvt_pk_bf16(h[4], h[5]); w.w = cvt_pk_bf16(h[6], h[7]);
                *(u32x4*)rowp = w; }
    }
};
struct EpiProj {
    static constexpr bool PERM = true, AFTER_DRAIN = false;
    bf16_t* O; int ldc; int gelu_tiles;
    __device__ __forceinline__ void operator()(const f32x4 (&acc)[2][2][4][2], const Unit& u, int wr, int wc, int fr, int fq) const {
        const int row0 = u.pm * BM + wr * 64 + fr; const int col0 = u.pn * BM + wc * 32 + 8 * fq; const bool act = u.pn < gelu_tiles;
#pragma unroll
        for (int ai = 0; ai < 2; ++ai)
#pragma unroll
            for (int m = 0; m < 4; ++m) { bf16_t* rowp = O + (size_t)(row0 + ai * HALF + m * 16) * ldc + col0;
#pragma unroll
                for (int bj = 0; bj < 2; ++bj) { float h[8];
#pragma unroll
                    for (int n = 0; n < 2; ++n)
#pragma unroll
                        for (int i = 0; i < 4; ++i) { float v = acc[ai][bj][m][n][i];
                            if (act) { const float t = 1.5957691216f * (v + 0.044715f * v * v * v); v = v * fast_sigmoid(t); }
                            h[n * 4 + i] = v; }
                    u32x4 w; w.x = cvt_pk_bf16(h[0], h[1]); w.y = cvt_pk_bf16(h[2], h[3]); w.z = cvt_pk_bf16(h[4], h[5]); w.w = cvt_pk_bf16(h[6], h[7]);
                    *(u32x4*)(rowp + bj * HALF) = w; } }
    }
};
struct EpiRes {
    static constexpr bool PERM = false, AFTER_DRAIN = false;
    float* X; int ldc; float alpha, cs;
    __device__ __forceinline__ void operator()(const f32x4 (&acc)[2][2][4][2], const Unit& u, int wr, int wc, int fr, int fq) const {
        const int col0 = u.pn * BM + wc * 32 + 4 * fq;
#pragma unroll
        for (int ai = 0; ai < 2; ++ai)
#pragma unroll
            for (int m = 0; m < 4; ++m) { float* rowp = X + (size_t)(u.pm * BM + ai * HALF + wr * 64 + m * 16 + fr) * ldc + col0;
#pragma unroll
                for (int bj = 0; bj < 2; ++bj)
#pragma unroll
                    for (int n = 0; n < 2; ++n) { f32x4* p = (f32x4*)(rowp + bj * HALF + n * 16); const f32x4 b = *p; f32x4 o = b * alpha + acc[ai][bj][m][n] * cs;
#ifdef DBG_NANFILTER
                        for (int e = 0; e < 4; ++e) if (!(fabsf(o[e]) < 1e30f)) o[e] = 12345.0f;
#endif
                        *p = o; } }
    }
};
template <class Epi, class Sched, bool ALIGN_EPI = false, bool SP2 = false>
__device__ __forceinline__ void gemm_phase(PG8_LAS unsigned char* lds, const Gemm g, const Sched& S, const Epi& E) {
    const int tid = opaque_tid(), wid = __builtin_amdgcn_readfirstlane(tid >> 6), lane = tid & 63, wr = wid >> 2, wc = wid & 3, fr = lane & 15, fq = lane >> 4;
    const int K = g.K, nt = K / BK;
    unsigned voffA[2], voffB[2];
#pragma unroll
    for (int i = 0; i < 2; ++i) { int R, C; stage_rc(tid * 16 + i * 8192, R, C); const int Rb = Epi::PERM ? ((R & ~31) + perm32(R & 31)) : R;
        voffA[i] = (unsigned)(R * K + C) * 2u; voffB[i] = (unsigned)(Rb * K + C) * 2u; }
    const size_t kstep = (size_t)(BK * 2);
    const size_t hstep = (size_t)HALF * K * 2;
    const size_t tstep = 2 * hstep;
    const unsigned ldsw = (unsigned)wid * 1024u;
    const int aoff = lds_byte(wr * 64 + fr, fq * 8), boff = lds_byte(wc * 32 + fr, fq * 8);
#define PG8_SA(b, h) (((b) * 2 + (h)) * HTB)
#define PG8_SB(b, h) ((4 + (b) * 2 + (h)) * HTB)
#define PG8_STAGE(bufoff, gbase, voff) do { _Pragma("unroll") for (int _i = 0; _i < 2; ++_i) \
        __builtin_amdgcn_global_load_lds((const unsigned*)((const char*)(gbase) + (voff)[_i]), (PG8_LAS unsigned*)(lds + (bufoff) + ldsw + _i * 8192), 16, 0, 0); } while (0)
#define PG8_LDA(dst, b, h) do { _Pragma("unroll") for (int m = 0; m < 4; ++m) _Pragma("unroll") for (int k = 0; k < 2; ++k) dst[m][k] = *(const PG8_LAS bf16x8*)(lds + PG8_SA(b, h) + aoff + m * 2048 + k * 1024); } while (0)
#define PG8_LDB(dst, b, h) do { _Pragma("unroll") for (int n = 0; n < 2; ++n) _Pragma("unroll") for (int k = 0; k < 2; ++k) dst[n][k] = *(const PG8_LAS bf16x8*)(lds + PG8_SB(b, h) + boff + n * 2048 + k * 1024); } while (0)
#define PG8_MMA(ai, bj, At, Bt) do { __builtin_amdgcn_s_setprio(1); _Pragma("unroll") for (int m = 0; m < 4; ++m) _Pragma("unroll") for (int n = 0; n < 2; ++n) _Pragma("unroll") for (int k = 0; k < 2; ++k) \
        acc[ai][bj][m][n] = __builtin_amdgcn_mfma_f32_16x16x32_bf16(Bt[n][k], At[m][k], acc[ai][bj][m][n], 0, 0, 0); __builtin_amdgcn_s_setprio(0); } while (0)
#define PG8_WAIT_V(n) asm volatile("s_waitcnt vmcnt(" #n ")" ::: "memory")
#define PG8_WAIT_L(n) asm volatile("s_waitcnt lgkmcnt(" #n ")" ::: "memory")
#define PG8_BAR __builtin_amdgcn_s_barrier()
#define PG8_SCHED __builtin_amdgcn_sched_barrier(0)
    Unit cur, nxt; int ui = 0;
    if (!S.next(0, cur)) return;
    f32x4 acc[2][2][4][2];
#pragma unroll
    for (int a = 0; a < 2; ++a)
#pragma unroll
        for (int b = 0; b < 2; ++b)
#pragma unroll
            for (int m = 0; m < 4; ++m)
#pragma unroll
                for (int n = 0; n < 2; ++n) acc[a][b][m][n] = (f32x4){0.f, 0.f, 0.f, 0.f};
    bf16x8 At[4][2], B0[2][2], B1[2][2];
    const char* cA = (const char*)g.A + (size_t)cur.pm * tstep; const char* cB = (const char*)g.Bt + (size_t)cur.pn * tstep;
    S.a_ready(cur);
    if constexpr (SP2) {
        PG8_STAGE(PG8_SB(0, 0), cB, voffB); PG8_STAGE(PG8_SB(0, 1), cB + hstep, voffB); PG8_STAGE(PG8_SA(0, 0), cA, voffA); PG8_STAGE(PG8_SA(0, 1), cA + hstep, voffA);
        if (wr == 1) PG8_BAR;
        PG8_WAIT_V(2); PG8_BAR;
        PG8_STAGE(PG8_SB(1, 0), cB + kstep, voffB); PG8_STAGE(PG8_SA(1, 0), cA + kstep, voffA); PG8_STAGE(PG8_SB(1, 1), cB + hstep + kstep, voffB);
        PG8_WAIT_V(6); PG8_BAR;
    } else {
        PG8_STAGE(PG8_SB(0, 0), cB, voffB); PG8_STAGE(PG8_SA(0, 0), cA, voffA); PG8_STAGE(PG8_SB(0, 1), cB + hstep, voffB); PG8_STAGE(PG8_SA(0, 1), cA + hstep, voffA);
        if (wr == 1) PG8_BAR;
        PG8_WAIT_V(4); PG8_BAR;
        PG8_STAGE(PG8_SB(1, 0), cB + kstep, voffB); PG8_STAGE(PG8_SA(1, 0), cA + kstep, voffA); PG8_STAGE(PG8_SB(1, 1), cB + hstep + kstep, voffB);
        PG8_WAIT_V(6); PG8_BAR;
    }
    for (;;) {
        const bool has_next = S.next(ui + 1, nxt);
        const char* nA = has_next ? (const char*)g.A + (size_t)nxt.pm * tstep : cA; const char* nB = has_next ? (const char*)g.Bt + (size_t)nxt.pn * tstep : cB;
        for (int t = 0; t < nt; t += 2) {
            const bool last = (t == nt - 2);
            const char* a1 = cA + (size_t)(t + 1) * kstep;
            const char* a2 = last ? nA : cA + (size_t)(t + 2) * kstep; const char* b2 = last ? nB : cB + (size_t)(t + 2) * kstep;
            const char* a3 = a2 + kstep; const char* b3 = b2 + kstep;
            if (last && has_next) S.a_ready(nxt);
            if constexpr (SP2) {
            PG8_LDB(B0, 0, 0); PG8_LDB(B1, 0, 1); PG8_SCHED; PG8_LDA(At, 0, 0); PG8_STAGE(PG8_SA(1, 1), a1 + hstep, voffA);
            PG8_WAIT_V(8); PG8_WAIT_L(0); PG8_BAR; PG8_MMA(0, 0, At, B0); PG8_MMA(0, 1, At, B1); PG8_BAR; PG8_SCHED;
            PG8_LDA(At, 0, 1); PG8_STAGE(PG8_SB(0, 0), b2, voffB); PG8_STAGE(PG8_SB(0, 1), b2 + hstep, voffB); PG8_STAGE(PG8_SA(0, 0), a2, voffA);
            PG8_WAIT_V(8); PG8_WAIT_L(0); PG8_BAR; PG8_MMA(1, 0, At, B0); PG8_MMA(1, 1, At, B1); PG8_BAR; PG8_SCHED;
            PG8_LDB(B0, 1, 0); PG8_LDB(B1, 1, 1); PG8_SCHED; PG8_LDA(At, 1, 0); PG8_STAGE(PG8_SA(0, 1), a2 + hstep, voffA);
            PG8_WAIT_V(8); PG8_WAIT_L(0); PG8_BAR; PG8_MMA(0, 0, At, B0); PG8_MMA(0, 1, At, B1); PG8_BAR; PG8_SCHED;
            PG8_LDA(At, 1, 1); PG8_STAGE(PG8_SB(1, 0), b3, voffB); PG8_STAGE(PG8_SB(1, 1), b3 + hstep, voffB); PG8_STAGE(PG8_SA(1, 0), a3, voffA);
            PG8_WAIT_V(8); PG8_WAIT_L(0); PG8_BAR; PG8_MMA(1, 0, At, B0); PG8_MMA(1, 1, At, B1); PG8_BAR; PG8_SCHED;
            } else {
            PG8_LDB(B0, 0, 0); PG8_SCHED; PG8_LDA(At, 0, 0); PG8_STAGE(PG8_SA(1, 1), a1 + hstep, voffA);
            PG8_WAIT_L(8); PG8_BAR; PG8_WAIT_L(0); PG8_MMA(0, 0, At, B0); PG8_BAR; PG8_SCHED;
            PG8_LDB(B1, 0, 1); PG8_STAGE(PG8_SB(0, 0), b2, voffB);
            PG8_BAR; PG8_WAIT_L(0); PG8_MMA(0, 1, At, B1); PG8_BAR;
            PG8_LDA(At, 0, 1); PG8_STAGE(PG8_SA(0, 0), a2, voffA);
            PG8_BAR; PG8_WAIT_L(0); PG8_MMA(1, 0, At, B0); PG8_BAR; PG8_SCHED;
            PG8_STAGE(PG8_SB(0, 1), b2 + hstep, voffB);
            PG8_WAIT_V(6); PG8_BAR; PG8_MMA(1, 1, At, B1); PG8_BAR;
            PG8_LDB(B0, 1, 0); PG8_SCHED; PG8_LDA(At, 1, 0); PG8_STAGE(PG8_SA(0, 1), a2 + hstep, voffA);
            PG8_WAIT_L(8); PG8_BAR; PG8_WAIT_L(0); PG8_MMA(0, 0, At, B0); PG8_BAR; PG8_SCHED;
            PG8_LDB(B1, 1, 1); PG8_STAGE(PG8_SB(1, 0), b3, voffB);
            PG8_BAR; PG8_WAIT_L(0); PG8_MMA(0, 1, At, B1); PG8_BAR;
            PG8_LDA(At, 1, 1); PG8_STAGE(PG8_SA(1, 0), a3, voffA);
            PG8_BAR; PG8_WAIT_L(0); PG8_MMA(1, 0, At, B0); PG8_BAR; PG8_SCHED;
            PG8_STAGE(PG8_SB(1, 1), b3 + hstep, voffB);
            PG8_WAIT_V(6); PG8_BAR; PG8_MMA(1, 1, At, B1); PG8_BAR;
            }
        }
        if constexpr (ALIGN_EPI) { if (wr == 0) PG8_BAR; }
        if constexpr (!Epi::AFTER_DRAIN) { E(acc, cur, wr, wc, fr, fq); S.done(cur); }
        if (!has_next) break;
#pragma unroll
        for (int a = 0; a < 2; ++a)
#pragma unroll
            for (int b = 0; b < 2; ++b)
#pragma unroll
                for (int m = 0; m < 4; ++m)
#pragma unroll
                    for (int n = 0; n < 2; ++n) acc[a][b][m][n] = (f32x4){0.f, 0.f, 0.f, 0.f};
        cur = nxt; cA = nA; cB = nB; ++ui;
        if constexpr (ALIGN_EPI) { if (wr == 1) PG8_BAR; }
    }
    PG8_WAIT_V(0);
    if constexpr (!ALIGN_EPI) { if (wr == 0) PG8_BAR; }
    PG8_BAR;
    if constexpr (Epi::AFTER_DRAIN) { E.fused(acc, cur, wr, wc, fr, fq, lds, wid, lane); S.done(cur); }
#undef PG8_SA
#undef PG8_SB
#undef PG8_STAGE
#undef PG8_LDA
#undef PG8_LDB
#undef PG8_MMA
#undef PG8_WAIT_V
#undef PG8_WAIT_L
#undef PG8_BAR
#undef PG8_SCHED
}
}
typedef unsigned short bf16;
typedef short bf16x8 __attribute__((ext_vector_type(8)));
typedef float f32x4 __attribute__((ext_vector_type(4)));
typedef unsigned u32x4 __attribute__((ext_vector_type(4)));
typedef unsigned u32x2 __attribute__((ext_vector_type(2)));
#define LAS __attribute__((address_space(3)))
constexpr int M = 16384, D = 1024, FF = 2816, DIN = 3360, DINP = 3584, SEQ = 8192, NLAYER = 4, NPH = 13;
constexpr float ALPHA = 1.681792830507429f, EPS = 1e-5f;
constexpr int C_AU = 0, C_AV = 256, C_BQ = 512, C_BZ = 2048, C_BBETA = 2560, C_BDEC = 2568, C_CQ = 2576, C_CK = 2704, C_CV = 2832, C_CR = 3088, C_CG = 3344;
constexpr size_t MiB = 1u << 20;
constexpr size_t WS_CTL = 0, WS_W = 1 * MiB, WS_XB = 44 * MiB, WS_HP = 76 * MiB, WS_MIX = 188 * MiB;
constexpr size_t OW13A = 0, OW2A = 11534336, OWIN = 17301504, OWOUT = 24641536, OW13B = 26738688, OW2B = 38273024, OWM = 42 * MiB;
constexpr size_t WS_UBT = 220 * MiB, WS_WN = 236 * MiB, WS_KDT = 252 * MiB, WS_PF = 268 * MiB, WS_QD = 284 * MiB, WS_SP = 300 * MiB, WS_UF = 316 * MiB, WS_GTOT = 332 * MiB;
constexpr size_t WS_OIT = 333 * MiB, WS_QDG = 349 * MiB, WS_BNT = 353 * MiB, WS_ST = 361 * MiB, WS_GT = 365 * MiB, WS_END = 366 * MiB;
constexpr int LDS_BYTES = 133120;
#ifndef PH_HI
#define PH_HI (NLAYER * NPH)
#endif
#ifndef MIXSEL
#define MIXSEL 7
#endif
#ifndef ONE_LAUNCH
#define ONE_LAUNCH 1
#endif

__device__ __forceinline__ float bf2f(bf16 b) { return __uint_as_float((unsigned)b << 16); }
__device__ __forceinline__ float bflo(unsigned u) { return __uint_as_float(u << 16); }
__device__ __forceinline__ float bfhi(unsigned u) { return __uint_as_float(u & 0xffff0000u); }
typedef float f32x2_t __attribute__((ext_vector_type(2))); typedef __bf16 bf16x2_t __attribute__((ext_vector_type(2)));
__device__ __forceinline__ unsigned pk2(float lo, float hi) { f32x2_t v = {lo, hi}; bf16x2_t b = __builtin_convertvector(v, bf16x2_t); return __builtin_bit_cast(unsigned, b); }
__device__ __forceinline__ bf16 f2bf(float f) { return (bf16)(pk2(f, 0.f) & 0xffffu); }
__device__ __forceinline__ float sigm(float x) { return 1.0f / (1.0f + __expf(-x)); }
__device__ __forceinline__ float softplusf(float x) { return fmaxf(x, 0.f) + log1pf(__expf(-fabsf(x))); }
__device__ __forceinline__ bf16x8 mk8(u32x2 a, u32x2 b) { u32x4 v = {a.x, a.y, b.x, b.y}; return __builtin_bit_cast(bf16x8, v); }
__device__ __forceinline__ bf16x8 as8(u32x4 v) { return __builtin_bit_cast(bf16x8, v); }
__device__ __forceinline__ f32x4 mfma16(bf16x8 a, bf16x8 b, f32x4 c) { return __builtin_amdgcn_mfma_f32_16x16x32_bf16(a, b, c, 0, 0, 0); }
__device__ __forceinline__ float wave_sum(float v) {
#pragma unroll
    for (int o = 1; o < 64; o <<= 1) v += __shfl_xor(v, o);
    return v;
}

struct KArgs { const float* in[26]; float* out; unsigned char* ws; int lo, hi; };

__device__ __forceinline__ void tr_item(const float* W, int K, int N, bf16* WT, int mode, float* scr, int item, int lane) {
    const int nblk = N / 32, kb = item / nblk, nb = item - kb * nblk, k0 = 64 * kb, n0 = 32 * nb;
    const int drow = (mode == 0) ? n0 : ((n0 >> 7) * 256 + (n0 & 127) + (mode == 2 ? 128 : 0));
#pragma unroll 8
    for (int i = 0; i < 32; ++i) { const int kk = 2 * i + (lane >> 5); scr[kk * 33 + (lane & 31)] = W[(size_t)(k0 + kk) * N + n0 + (lane & 31)]; }
    asm volatile("s_waitcnt lgkmcnt(0)" ::: "memory");
    const int c = lane & 7;
#pragma unroll
    for (int j = 0; j < 4; ++j) { const int n = (lane >> 3) + 8 * j; const float* s = scr + (8 * c) * 33 + n;
        u32x4 o; o.x = pk2(s[0 * 33], s[1 * 33]); o.y = pk2(s[2 * 33], s[3 * 33]); o.z = pk2(s[4 * 33], s[5 * 33]); o.w = pk2(s[6 * 33], s[7 * 33]);
        *(u32x4*)(WT + (size_t)(drow + n) * K + k0 + 8 * c) = o; }
    asm volatile("s_waitcnt lgkmcnt(0)" ::: "memory");
}

__device__ __forceinline__ void phase_conv(const KArgs& a, int l, unsigned char* lds) {
    const int tid = opaque_tid(), lane = tid & 63, wave = tid >> 6;
    float* scr = (float*)(lds + wave * 8704);
    unsigned char* wb = a.ws + WS_W;
    const int gw = opaque_bid() * 8 + wave, NGW = gridDim.x * 8;
    constexpr int I_FF = 1408, I_IN = 1680, I_OUT = 512, NITEMS = 6 * I_FF + I_IN + I_OUT;
    for (int it = gw; it < NITEMS; it += NGW) {
        int r = it;
        if (r < I_FF) { tr_item(a.in[1] + (size_t)l * D * FF, D, FF, (bf16*)(wb + OW13A), 1, scr, r, lane); continue; } r -= I_FF;
        if (r < I_FF) { tr_item(a.in[2] + (size_t)l * D * FF, D, FF, (bf16*)(wb + OW13A), 2, scr, r, lane); continue; } r -= I_FF;
        if (r < I_FF) { tr_item(a.in[3] + (size_t)l * D * FF, FF, D, (bf16*)(wb + OW2A), 0, scr, r, lane); continue; } r -= I_FF;
        if (r < I_IN) { tr_item(a.in[6] + (size_t)l * D * DIN, D, DIN, (bf16*)(wb + OWIN), 0, scr, r, lane); continue; } r -= I_IN;
        if (r < I_OUT) { tr_item(a.in[18] + (size_t)l * D * D, D, D, (bf16*)(wb + OWOUT), 0, scr, r, lane); continue; } r -= I_OUT;
        if (r < I_FF) { tr_item(a.in[21] + (size_t)l * D * FF, D, FF, (bf16*)(wb + OW13B), 1, scr, r, lane); continue; } r -= I_FF;
        if (r < I_FF) { tr_item(a.in[22] + (size_t)l * D * FF, D, FF, (bf16*)(wb + OW13B), 2, scr, r, lane); continue; } r -= I_FF;
        tr_item(a.in[23] + (size_t)l * D * FF, FF, D, (bf16*)(wb + OW2B), 0, scr, r, lane);
    }
    const int gt = opaque_bid() * 512 + tid, NGT = gridDim.x * 512;
    { u32x4* p = (u32x4*)(wb + OWIN + (size_t)DIN * D * 2); const int n16 = (DINP - DIN) * D * 2 / 16;
      for (int i = gt; i < n16; i += NGT) p[i] = (u32x4){0u, 0u, 0u, 0u}; }
    { const float* sw = a.in[9] + (size_t)l * 65536; bf16* wm = (bf16*)(wb + OWM);
      for (int i = gt; i < 65536; i += NGT) { const int ii = (i >> 7) & 127, jj = i & 127; wm[i] = (jj <= ii) ? f2bf(sw[i]) : (bf16)0; } }
    if (l == 0) {
        const f32x4* xs = (const f32x4*)a.in[0]; f32x4* xo = (f32x4*)a.out; u32x2* xb = (u32x2*)(a.ws + WS_XB);
        for (int i = gt; i < M * D / 4; i += NGT) { const f32x4 v = xs[i]; xo[i] = v; xb[i] = (u32x2){pk2(v.x, v.y), pk2(v.z, v.w)}; }
    }
}

__device__ __forceinline__ void phase_ln(const KArgs& a, const float* g, const float* b) {
    const int tid = opaque_tid(), lane = tid & 63, wave = tid >> 6;
    const int gw = opaque_bid() * 8 + wave, NGW = gridDim.x * 8;
    f32x4 gv[4], bv[4];
#pragma unroll
    for (int j = 0; j < 4; ++j) { gv[j] = ((const f32x4*)g)[64 * j + lane]; bv[j] = ((const f32x4*)b)[64 * j + lane]; }
    for (int m = gw; m < M; m += NGW) {
        f32x4* xr = (f32x4*)(a.out + (size_t)m * D) + lane; u32x2* xb = (u32x2*)(a.ws + WS_XB + (size_t)m * D * 2) + lane;
        f32x4 v[4]; float s = 0.f;
#pragma unroll
        for (int j = 0; j < 4; ++j) { v[j] = xr[64 * j]; s += (v[j].x + v[j].y) + (v[j].z + v[j].w); }
        const float mean = wave_sum(s) * (1.f / D); float s2 = 0.f;
#pragma unroll
        for (int j = 0; j < 4; ++j) { v[j] = v[j] - mean; s2 += (v[j].x * v[j].x + v[j].y * v[j].y) + (v[j].z * v[j].z + v[j].w * v[j].w); }
        const float rstd = 1.f / sqrtf(wave_sum(s2) * (1.f / D) + EPS);
#pragma unroll
        for (int j = 0; j < 4; ++j) { const f32x4 y = v[j] * rstd * gv[j] + bv[j]; xr[64 * j] = y; xb[64 * j] = (u32x2){pk2(y.x, y.y), pk2(y.z, y.w)}; }
    }
}
__device__ __forceinline__ void m1_gdn(const KArgs& a, int l, int item, unsigned char* lds) {
    const int tid = opaque_tid(), lane = tid & 63, wave = tid >> 6, slot = wave >> 2, sw = wave & 3, tid4 = tid & 255;
    const int r = lane & 15, q = lane >> 4;
    const int unit = item * 2 + slot, b = unit >> 10, h = (unit >> 7) & 7, n = unit & 127;
    const int row0 = b * SEQ + n * 64;
    unsigned char* sl = lds + slot * 45056;
    bf16* qbf = (bf16*)sl; bf16* kbf = (bf16*)(sl + 9216); bf16* vbf = (bf16*)(sl + 18432);
    float* Lf = (float*)(sl + 27648); bf16* Wl = (bf16*)(sl + 27648);
    float* betaL = (float*)(sl + 44032); float* gamL = (float*)(sl + 44288);
    const bf16* HP = (const bf16*)(a.ws + WS_HP);
    const float* cw = a.in[11] + (size_t)l * 4 * 1536;
#pragma unroll 1
    for (int it = 0; it < 6; ++it) {
        const int e = it * 256 + tid4, tok = e / 24, g = e - tok * 24, ten = g >> 3, sub = g & 7;
        const int chh = ten * 512 + h * 64 + sub * 8;
        float y[8];
#pragma unroll
        for (int i = 0; i < 8; ++i) y[i] = 0.f;
#pragma unroll
        for (int tap = 0; tap < 4; ++tap) {
            const int tt = tok - 3 + tap;
            if (n * 64 + tt >= 0) {
                const u32x4 xv = *(const u32x4*)(HP + (size_t)(row0 + tt) * DINP + C_BQ + chh);
                const f32x4 w0 = *(const f32x4*)(cw + tap * 1536 + chh), w1 = *(const f32x4*)(cw + tap * 1536 + chh + 4);
                y[0] += w0.x * bflo(xv.x); y[1] += w0.y * bfhi(xv.x); y[2] += w0.z * bflo(xv.y); y[3] += w0.w * bfhi(xv.y);
                y[4] += w1.x * bflo(xv.z); y[5] += w1.y * bfhi(xv.z); y[6] += w1.z * bflo(xv.w); y[7] += w1.w * bfhi(xv.w);
            }
        }
        float ss = 0.f;
#pragma unroll
        for (int i = 0; i < 8; ++i) { y[i] = y[i] * sigm(y[i]); ss += y[i] * y[i]; }
        ss += __shfl_xor(ss, 1); ss += __shfl_xor(ss, 2); ss += __shfl_xor(ss, 4);
        const float inv = (ten == 2) ? 1.f : (rsqrtf(ss + 1e-6f) * (ten == 0 ? 0.125f : 1.f));
        u32x4 o; o.x = pk2(y[0] * inv, y[1] * inv); o.y = pk2(y[2] * inv, y[3] * inv); o.z = pk2(y[4] * inv, y[5] * inv); o.w = pk2(y[6] * inv, y[7] * inv);
        bf16* dst = (ten == 0 ? qbf : (ten == 1 ? kbf : vbf)) + tok * 72 + sub * 8;
        *(u32x4*)dst = o;
    }
    if (tid4 < 64) {
        const int tok = tid4;
        const float bl = bf2f(HP[(size_t)(row0 + tok) * DINP + C_BBETA + h]), dl = bf2f(HP[(size_t)(row0 + tok) * DINP + C_BDEC + h]);
        const float beta = sigm(bl);
        float lg = -expf(a.in[12][l * 8 + h]) * softplusf(dl + a.in[13][l * 8 + h]);
#pragma unroll
        for (int off = 1; off < 64; off <<= 1) { const float t = __shfl_up(lg, off); if (lane >= off) lg += t; }
        betaL[tok] = beta; gamL[tok] = lg;
    }
    __syncthreads();
    {
        const int it_ = sw;
        bf16x8 ka[2], qb[2];
#pragma unroll
        for (int ks = 0; ks < 2; ++ks) { ka[ks] = *(const bf16x8*)(kbf + (16 * it_ + r) * 72 + 32 * ks + 8 * q); qb[ks] = *(const bf16x8*)(qbf + (16 * it_ + r) * 72 + 32 * ks + 8 * q); }
        u32x2 pp[4];
#pragma unroll
        for (int jt = 0; jt < 4; ++jt) {
            pp[jt] = (u32x2){0u, 0u};
            if (jt <= it_) {
                bf16x8 kb[2];
#pragma unroll
                for (int ks = 0; ks < 2; ++ks) kb[ks] = *(const bf16x8*)(kbf + (16 * jt + r) * 72 + 32 * ks + 8 * q);
                f32x4 acc = {0.f, 0.f, 0.f, 0.f};
                acc = mfma16(ka[0], kb[0], acc); acc = mfma16(ka[1], kb[1], acc);
                { const int j = 16 * jt + r; const float gj = gamL[j];
#pragma unroll
                  for (int ii = 0; ii < 4; ++ii) { const int i = 16 * it_ + 4 * q + ii; Lf[i * 64 + j] = (j < i) ? betaL[i] * acc[ii] * __expf(gamL[i] - gj) : 0.f; } }
                f32x4 pc = {0.f, 0.f, 0.f, 0.f};
                pc = mfma16(kb[0], qb[0], pc); pc = mfma16(kb[1], qb[1], pc);
                { const int i = 16 * it_ + r; const float gi = gamL[i]; float pv[4];
#pragma unroll
                  for (int jj = 0; jj < 4; ++jj) { const int j = 16 * jt + 4 * q + jj; pv[jj] = (j <= i) ? pc[jj] * __expf(gi - gamL[j]) : 0.f; }
                  pp[jt] = (u32x2){pk2(pv[0], pv[1]), pk2(pv[2], pv[3])}; }
            }
        }
        u32x4* Pf = (u32x4*)(a.ws + WS_PF) + ((size_t)(unit * 4 + it_) * 2) * 64 + lane;
        Pf[0] = (u32x4){pp[0].x, pp[0].y, pp[1].x, pp[1].y};
        Pf[64] = (u32x4){pp[2].x, pp[2].y, pp[3].x, pp[3].y};
    }
    __syncthreads();
    float x[64];
    if (tid4 < 128) {
        const bool isk = tid4 >= 64; const int cc = tid4 & 63;
        const bf16* src = isk ? kbf : vbf;
#pragma unroll
        for (int i = 0; i < 64; ++i) {
            const float bi = betaL[i];
            float s = bf2f(src[i * 72 + cc]) * (isk ? bi * __expf(gamL[i]) : bi);
#pragma unroll
            for (int jj = 0; jj < (i + 3) / 4; ++jj) {
                const f32x4 Lr = *(const f32x4*)(Lf + i * 64 + 4 * jj);
#pragma unroll
                for (int e = 0; e < 4; ++e) if (4 * jj + e < i) s -= Lr[e] * x[4 * jj + e];
            }
            x[i] = s;
            asm volatile("" : "+v"(x[i]) :: "memory");
        }
    } else {
        const int t2 = tid4 - 128; const float glast = gamL[63];
        bf16* Qd = (bf16*)(a.ws + WS_QD) + (size_t)unit * 4096; bf16* KdT = (bf16*)(a.ws + WS_KDT) + (size_t)unit * 4096;
#pragma unroll 1
        for (int e = t2; e < 512; e += 128) { const int tok = e >> 3, sub = e & 7; const float sc = __expf(gamL[tok]);
            const u32x4 v = *(const u32x4*)(qbf + tok * 72 + sub * 8);
            u32x4 o; o.x = pk2(bflo(v.x) * sc, bfhi(v.x) * sc); o.y = pk2(bflo(v.y) * sc, bfhi(v.y) * sc); o.z = pk2(bflo(v.z) * sc, bfhi(v.z) * sc); o.w = pk2(bflo(v.w) * sc, bfhi(v.w) * sc);
            *(u32x4*)(Qd + tok * 64 + sub * 8) = o; }
#pragma unroll 1
        for (int e = t2; e < 512; e += 128) { const int dk = e & 63, kq = e >> 6, ks = kq >> 2, qq = kq & 3, tb = 32 * ks + 4 * qq; float v[8];
#pragma unroll
            for (int tt = 0; tt < 4; ++tt) { v[tt] = bf2f(kbf[(tb + tt) * 72 + dk]) * __expf(glast - gamL[tb + tt]); v[4 + tt] = bf2f(kbf[(tb + 16 + tt) * 72 + dk]) * __expf(glast - gamL[tb + 16 + tt]); }
            u32x4 o; o.x = pk2(v[0], v[1]); o.y = pk2(v[2], v[3]); o.z = pk2(v[4], v[5]); o.w = pk2(v[6], v[7]);
            *(u32x4*)(KdT + ((((dk >> 4) * 2 + ks) * 64) + qq * 16 + (dk & 15)) * 8) = o; }
        if (t2 == 0) ((float*)(a.ws + WS_GTOT))[unit] = __expf(glast);
    }
    __syncthreads();
    if (tid4 < 64) {
        bf16* ubb = (bf16*)(a.ws + WS_UBT) + (size_t)unit * 4096;
#pragma unroll
        for (int qq = 0; qq < 4; ++qq) {
            u32x4* p = (u32x4*)(ubb + (((tid4 >> 4) * 64 + qq * 16 + (tid4 & 15)) * 4) * 4);
            p[0] = (u32x4){pk2(x[4 * qq], x[4 * qq + 1]), pk2(x[4 * qq + 2], x[4 * qq + 3]), pk2(x[16 + 4 * qq], x[16 + 4 * qq + 1]), pk2(x[16 + 4 * qq + 2], x[16 + 4 * qq + 3])};
            p[1] = (u32x4){pk2(x[32 + 4 * qq], x[32 + 4 * qq + 1]), pk2(x[32 + 4 * qq + 2], x[32 + 4 * qq + 3]), pk2(x[48 + 4 * qq], x[48 + 4 * qq + 1]), pk2(x[48 + 4 * qq + 2], x[48 + 4 * qq + 3])};
        }
    } else if (tid4 < 128) {
        const int cc = tid4 - 64;
#pragma unroll
        for (int i = 0; i < 64; ++i) Wl[i * 72 + cc] = f2bf(-x[i]);
    }
    __syncthreads();
    {
        bf16* Wn = (bf16*)(a.ws + WS_WN) + (size_t)unit * 4096;
#pragma unroll
        for (int e = tid4; e < 512; e += 256) { const int f = e >> 6, ln = e & 63, t = f >> 1, ks = f & 1; const bf16* wp = Wl + (16 * t + (ln & 15)) * 72 + 32 * ks + 4 * (ln >> 4);
            const u32x2 lo = *(const u32x2*)wp, hi = *(const u32x2*)(wp + 16); *(u32x4*)(Wn + e * 8) = (u32x4){lo.x, lo.y, hi.x, hi.y}; }
    }
}

__device__ __forceinline__ void m1_sgu(const KArgs& a, int l, int unit, unsigned char* lds) {
    const int tid = opaque_tid(), lane = tid & 63, wave = tid >> 6, r = lane & 15, q = lane >> 4;
    const int b = unit >> 6, n = unit & 63, row0 = b * SEQ + n * 128;
    const bf16* HP = (const bf16*)(a.ws + WS_HP);
    bf16* vnT = (bf16*)lds;
    const float* lg = a.in[7] + l * 256; const float* lb = a.in[8] + l * 256;
    float gch[4], bch[4];
#pragma unroll
    for (int i = 0; i < 4; ++i) { gch[i] = lg[lane + 64 * i]; bch[i] = lb[lane + 64 * i]; }
#pragma unroll 4
    for (int tt = 0; tt < 16; ++tt) {
        const int tok = wave * 16 + tt; const bf16* src = HP + (size_t)(row0 + tok) * DINP + C_AV;
        float v[4]; float s = 0.f;
#pragma unroll
        for (int i = 0; i < 4; ++i) { v[i] = bf2f(src[lane + 64 * i]); s += v[i]; }
        const float mean = wave_sum(s) * (1.f / 256.f); float s2 = 0.f;
#pragma unroll
        for (int i = 0; i < 4; ++i) { v[i] -= mean; s2 += v[i] * v[i]; }
        const float rstd = rsqrtf(wave_sum(s2) * (1.f / 256.f) + EPS);
#pragma unroll
        for (int i = 0; i < 4; ++i) vnT[(lane + 64 * i) * 136 + tok] = f2bf(v[i] * rstd * gch[i] + bch[i]);
    }
    __syncthreads();
    const int h = wave >> 1, ih = wave & 1;
    const bf16* Wm = (const bf16*)(a.ws + WS_W + OWM) + h * 16384;
    f32x4 acc[4][4];
#pragma unroll
    for (int it = 0; it < 4; ++it)
#pragma unroll
        for (int dt = 0; dt < 4; ++dt) acc[it][dt] = (f32x4){0.f, 0.f, 0.f, 0.f};
#pragma unroll
    for (int ks = 0; ks < 4; ++ks) {
        if (32 * ks <= 64 * ih + 63) {
            bf16x8 av[4];
#pragma unroll
            for (int dt = 0; dt < 4; ++dt) av[dt] = *(const bf16x8*)(vnT + (h * 64 + 16 * dt + r) * 136 + 32 * ks + 8 * q);
#pragma unroll
            for (int it = 0; it < 4; ++it) {
                const bf16x8 bw = *(const bf16x8*)(Wm + (64 * ih + 16 * it + r) * 128 + 32 * ks + 8 * q);
#pragma unroll
                for (int dt = 0; dt < 4; ++dt) acc[it][dt] = mfma16(av[dt], bw, acc[it][dt]);
            }
        }
    }
    const float* sb = a.in[10] + (size_t)l * 512 + h * 128;
    bf16* MIX = (bf16*)(a.ws + WS_MIX);
#pragma unroll
    for (int it = 0; it < 4; ++it) {
        const int tok = 64 * ih + 16 * it + r; const float bias = sb[tok];
#pragma unroll
        for (int dt = 0; dt < 4; ++dt) {
            const int d0 = h * 64 + 16 * dt + 4 * q;
            const u32x2 uv = *(const u32x2*)(HP + (size_t)(row0 + tok) * DINP + C_AU + d0);
            f32x4 z = acc[it][dt]; if (!(MIXSEL & 1)) z = (f32x4){0.f, 0.f, 0.f, 0.f};
            *(u32x2*)(MIX + (size_t)(row0 + tok) * D + d0) = (u32x2){pk2(bflo(uv.x) * (z[0] + bias), bfhi(uv.x) * (z[1] + bias)), pk2(bflo(uv.y) * (z[2] + bias), bfhi(uv.y) * (z[3] + bias))};
        }
    }
}

__device__ __forceinline__ void m1_gla(const KArgs& a, int l, int item, unsigned char* lds) {
    const int tid = opaque_tid(), lane = tid & 63, wave = tid >> 6, r = lane & 15, q = lane >> 4;
    const int unit = item * 8 + wave, b = unit >> 9, h = (unit >> 7) & 3, n = unit & 127, row0 = b * SEQ + n * 64;
    unsigned char* wl = lds + wave * 14336;
    bf16* qdL = (bf16*)wl; bf16* knL = (bf16*)(wl + 5120);
    bf16* vT = (bf16*)wl; bf16* kdT = (bf16*)(wl + 9216);
    const bf16* HP = (const bf16*)(a.ws + WS_HP);
    const int dk = lane & 31, half = lane >> 5;
    float gu[16];
#pragma unroll
    for (int i = 0; i < 16; ++i) gu[i] = a.in[15][(size_t)l * 2048 + i * 128 + h * 32 + dk];
    const float gb = a.in[16][l * 128 + h * 32 + dk];
    float bc[32];
#pragma unroll
    for (int t = 0; t < 32; ++t) {
        const int tok = half * 32 + t; const u32x4* gp = (const u32x4*)(HP + (size_t)(row0 + tok) * DINP + C_CG);
        const u32x4 g0 = gp[0], g1 = gp[1];
        float dot = gb;
        dot += bflo(g0.x) * gu[0] + bfhi(g0.x) * gu[1] + bflo(g0.y) * gu[2] + bfhi(g0.y) * gu[3] + bflo(g0.z) * gu[4] + bfhi(g0.z) * gu[5] + bflo(g0.w) * gu[6] + bfhi(g0.w) * gu[7];
        dot += bflo(g1.x) * gu[8] + bfhi(g1.x) * gu[9] + bflo(g1.y) * gu[10] + bfhi(g1.y) * gu[11] + bflo(g1.z) * gu[12] + bfhi(g1.z) * gu[13] + bflo(g1.w) * gu[14] + bfhi(g1.w) * gu[15];
        const float la = -softplusf(-dot) * (1.f / 16.f);
        bc[t] = (t ? bc[t - 1] : 0.f) + la;
    }
    const float tot0 = __shfl(bc[31], dk);
    if (half) {
#pragma unroll
        for (int t = 0; t < 32; ++t) bc[t] += tot0;
    }
    const float blast = __shfl(bc[31], dk + 32);
    bf16* QdG = (bf16*)(a.ws + WS_QDG) + (size_t)unit * 2048;
    unsigned kdp[16];
#pragma unroll
    for (int t = 0; t < 32; t += 2) {
        float kd2[2];
#pragma unroll
        for (int u = 0; u < 2; ++u) {
            const int tok = half * 32 + t + u; const size_t ro = (size_t)(row0 + tok) * DINP;
            const float qv = bf2f(HP[ro + C_CQ + h * 32 + dk]), kv = bf2f(HP[ro + C_CK + h * 32 + dk]);
            const float bcv = bc[t + u];
            const bf16 qd = f2bf(qv * 0.17677669529663687f * __expf(bcv));
            qdL[tok * 40 + dk] = qd; QdG[tok * 32 + dk] = qd;
            knL[tok * 40 + dk] = f2bf(kv * __expf(-bcv));
            kd2[u] = kv * __expf(blast - bcv);
        }
        kdp[t >> 1] = pk2(kd2[0], kd2[1]);
    }
    if (half) ((float*)(a.ws + WS_GT))[unit * 32 + dk] = __expf(blast);
    asm volatile("s_waitcnt lgkmcnt(0)" ::: "memory");
    u32x2 pp[4][4];
#pragma unroll
    for (int it = 0; it < 4; ++it) {
        const bf16x8 qf = *(const bf16x8*)(qdL + (16 * it + r) * 40 + 8 * q);
#pragma unroll
        for (int jt = 0; jt < 4; ++jt) {
            pp[it][jt] = (u32x2){0u, 0u};
            if (jt <= it) {
                const bf16x8 kf = *(const bf16x8*)(knL + (16 * jt + r) * 40 + 8 * q);
                f32x4 pc = {0.f, 0.f, 0.f, 0.f};
                pc = mfma16(kf, qf, pc);
                const int i = 16 * it + r; float pv[4];
#pragma unroll
                for (int jj = 0; jj < 4; ++jj) { const int j = 16 * jt + 4 * q + jj; pv[jj] = (j <= i) ? pc[jj] : 0.f; }
                pp[it][jt] = (u32x2){pk2(pv[0], pv[1]), pk2(pv[2], pv[3])};
            }
        }
    }
    asm volatile("s_waitcnt lgkmcnt(0)" ::: "memory");
#pragma unroll
    for (int t = 0; t < 32; t += 2) { const int tok = half * 32 + t; *(unsigned*)(kdT + dk * 72 + tok) = kdp[t >> 1]; }
#pragma unroll 2
    for (int it = 0; it < 8; ++it) {
        const int e = it * 64 + lane, tok = e >> 3, g = e & 7;
        const u32x4 v = *(const u32x4*)(HP + (size_t)(row0 + tok) * DINP + C_CV + h * 64 + g * 8);
        bf16* d = vT + (g * 8) * 72 + tok;
        d[0] = (bf16)(v.x & 0xffffu); d[72] = (bf16)(v.x >> 16); d[144] = (bf16)(v.y & 0xffffu); d[216] = (bf16)(v.y >> 16);
        d[288] = (bf16)(v.z & 0xffffu); d[360] = (bf16)(v.z >> 16); d[432] = (bf16)(v.w & 0xffffu); d[504] = (bf16)(v.w >> 16);
    }
    asm volatile("s_waitcnt lgkmcnt(0)" ::: "memory");
    f32x4* OiT = (f32x4*)(a.ws + WS_OIT) + (size_t)unit * 1024 + lane;
#pragma unroll
    for (int dt = 0; dt < 4; ++dt) {
        bf16x8 va[2];
#pragma unroll
        for (int ks = 0; ks < 2; ++ks) va[ks] = mk8(*(const u32x2*)(vT + (16 * dt + r) * 72 + 32 * ks + 4 * q), *(const u32x2*)(vT + (16 * dt + r) * 72 + 32 * ks + 16 + 4 * q));
#pragma unroll
        for (int it = 0; it < 4; ++it) {
            f32x4 acc = {0.f, 0.f, 0.f, 0.f};
            acc = mfma16(va[0], mk8(pp[it][0], pp[it][1]), acc);
            if (it >= 2) acc = mfma16(va[1], mk8(pp[it][2], pp[it][3]), acc);
            OiT[(it * 4 + dt) * 64] = acc;
        }
    }
    float* BnT = (float*)(a.ws + WS_BNT) + (size_t)unit * 2048;
#pragma unroll
    for (int dt = 0; dt < 4; ++dt) {
        bf16x8 va[2];
#pragma unroll
        for (int ks = 0; ks < 2; ++ks) va[ks] = *(const bf16x8*)(vT + (16 * dt + r) * 72 + 32 * ks + 8 * q);
#pragma unroll
        for (int kt = 0; kt < 2; ++kt) {
            f32x4 acc = {0.f, 0.f, 0.f, 0.f};
#pragma unroll
            for (int ks = 0; ks < 2; ++ks) acc = mfma16(va[ks], *(const bf16x8*)(kdT + (16 * kt + r) * 72 + 32 * ks + 8 * q), acc);
#pragma unroll
            for (int i = 0; i < 4; ++i) BnT[(16 * dt + 4 * q + i) * 32 + 16 * kt + r] = acc[i];
        }
    }
}

__device__ __forceinline__ void phase_m1(const KArgs& a, int l, unsigned char* lds) {
    for (int item = opaque_bid(); item < 1280; item += gridDim.x) {
        __syncthreads();
        if (item < 1024) m1_gdn(a, l, item, lds);
        else if (item < 1152) m1_sgu(a, l, item - 1024, lds);
        else m1_gla(a, l, item - 1152, lds);
    }
}
__device__ __forceinline__ void phase_m2(const KArgs& a, unsigned char* lds) {
    const int tid = opaque_tid(), lane = tid & 63, wave = tid >> 6, r = lane & 15, q = lane >> 4;
    const int blk = opaque_bid();
    if (blk < 64) {
        const int b = blk >> 5, h = (blk >> 2) & 7, s = blk & 3;
        const int u0 = (b * 8 + h) * 128;
        LAS unsigned char* L = (LAS unsigned char*)lds;
        volatile LAS unsigned* flags = (volatile LAS unsigned*)(L + 131072 + 128);
        constexpr int SLOT = 18448;
        if (tid < 16) flags[tid] = 0u;
        __syncthreads();
        if (wave == 0) {
            u32x4* SP = (u32x4*)(a.ws + WS_SP); u32x4* UF = (u32x4*)(a.ws + WS_UF);
            f32x4 S[4];
#pragma unroll
            for (int mt = 0; mt < 4; ++mt) S[mt] = (f32x4){0.f, 0.f, 0.f, 0.f};
            int slot = 0;
#pragma unroll 1
            for (int n = 0; n < 128; ++n) {
                const int uidx = u0 + n;
                LAS unsigned char* base = L + slot * SLOT;
                while (flags[slot] != (unsigned)(n + 1)) __builtin_amdgcn_s_sleep(1);
                asm volatile("" ::: "memory");
                bf16x8 wa[4][2], ka[4][2]; f32x4 u[4];
#pragma unroll
                for (int t = 0; t < 4; ++t)
#pragma unroll
                    for (int ks = 0; ks < 2; ++ks) { wa[t][ks] = *(const LAS bf16x8*)(base + ((t * 2 + ks) * 64 + lane) * 16); ka[t][ks] = *(const LAS bf16x8*)(base + 8192 + ((t * 2 + ks) * 64 + lane) * 16); }
                const u32x4 ub0 = *(const LAS u32x4*)(base + 16384 + lane * 32), ub1 = *(const LAS u32x4*)(base + 16384 + lane * 32 + 16);
                const float gc = *(const LAS float*)(base + 18432);
                asm volatile("s_waitcnt lgkmcnt(0)" ::: "memory");
                if (lane == 0) flags[8] = (unsigned)(n + 1);
                u[0] = (f32x4){bflo(ub0.x), bfhi(ub0.x), bflo(ub0.y), bfhi(ub0.y)}; u[1] = (f32x4){bflo(ub0.z), bfhi(ub0.z), bflo(ub0.w), bfhi(ub0.w)};
                u[2] = (f32x4){bflo(ub1.x), bfhi(ub1.x), bflo(ub1.y), bfhi(ub1.y)}; u[3] = (f32x4){bflo(ub1.z), bfhi(ub1.z), bflo(ub1.w), bfhi(ub1.w)};
                u32x4 sb[2];
#pragma unroll
                for (int ks = 0; ks < 2; ++ks) sb[ks] = (u32x4){pk2(S[2 * ks][0], S[2 * ks][1]), pk2(S[2 * ks][2], S[2 * ks][3]), pk2(S[2 * ks + 1][0], S[2 * ks + 1][1]), pk2(S[2 * ks + 1][2], S[2 * ks + 1][3])};
                SP[((size_t)(uidx * 4 + s) * 2 + 0) * 64 + lane] = sb[0]; SP[((size_t)(uidx * 4 + s) * 2 + 1) * 64 + lane] = sb[1];
#pragma unroll
                for (int ks = 0; ks < 2; ++ks)
#pragma unroll
                    for (int t = 0; t < 4; ++t) u[t] = mfma16(wa[t][ks], as8(sb[ks]), u[t]);
                u32x4 up2[2];
#pragma unroll
                for (int ks = 0; ks < 2; ++ks) up2[ks] = (u32x4){pk2(u[2 * ks][0], u[2 * ks][1]), pk2(u[2 * ks][2], u[2 * ks][3]), pk2(u[2 * ks + 1][0], u[2 * ks + 1][1]), pk2(u[2 * ks + 1][2], u[2 * ks + 1][3])};
                UF[((size_t)(uidx * 4 + s) * 2 + 0) * 64 + lane] = up2[0]; UF[((size_t)(uidx * 4 + s) * 2 + 1) * 64 + lane] = up2[1];
#pragma unroll
                for (int t = 0; t < 4; ++t) S[t] = S[t] * gc;
#pragma unroll
                for (int ks = 0; ks < 2; ++ks)
#pragma unroll
                    for (int t = 0; t < 4; ++t) S[t] = mfma16(ka[t][ks], as8(up2[ks]), S[t]);
                slot = (slot == 6) ? 0 : slot + 1;
            }
        } else {
            const int w1 = wave - 1;
            LAS unsigned char* base = L + w1 * SLOT;
#pragma unroll 1
            for (int n = w1; n < 128; n += 7) {
                const int uidx = u0 + n;
                const u32x4* Wg = (const u32x4*)((const bf16*)(a.ws + WS_WN) + (size_t)uidx * 4096) + lane;
                const u32x4* Kg = (const u32x4*)((const bf16*)(a.ws + WS_KDT) + (size_t)uidx * 4096) + lane;
                const u32x4* Ug = (const u32x4*)((const bf16*)(a.ws + WS_UBT) + (size_t)uidx * 4096 + s * 1024) + lane;
                u32x4 d[18];
#pragma unroll
                for (int i = 0; i < 8; ++i) { d[i] = Wg[i * 64]; d[8 + i] = Kg[i * 64]; }
                d[16] = Ug[0]; d[17] = Ug[64];
                const float g = ((const float*)(a.ws + WS_GTOT))[uidx];
                if (n >= 7) { while (flags[8] < (unsigned)(n - 6)) __builtin_amdgcn_s_sleep(1); }
                asm volatile("" ::: "memory");
#pragma unroll
                for (int i = 0; i < 8; ++i) { *(LAS u32x4*)(base + (i * 64 + lane) * 16) = d[i]; *(LAS u32x4*)(base + 8192 + (i * 64 + lane) * 16) = d[8 + i]; }
                *(LAS u32x4*)(base + 16384 + lane * 16) = d[16]; *(LAS u32x4*)(base + 16384 + 1024 + lane * 16) = d[17];
                if (lane == 0) *(LAS float*)(base + 18432) = g;
                asm volatile("s_waitcnt lgkmcnt(0)" ::: "memory");
                if (lane == 0) flags[w1] = (unsigned)(n + 1);
            }
        }
    } else if (blk < 96) {
        const int gid = (blk - 64) * 512 + tid, bh = gid >> 11, rem = gid & 2047;
        const int dk = rem & 31;
        const float* BnT = (const float*)(a.ws + WS_BNT) + (size_t)bh * 128 * 2048 + rem;
        const float* Gt = (const float*)(a.ws + WS_GT) + (size_t)bh * 128 * 32 + dk;
        bf16* ST = (bf16*)(a.ws + WS_ST) + (size_t)bh * 128 * 2048 + rem;
        float S = 0.f;
#pragma unroll 1
        for (int n0 = 0; n0 < 128; n0 += 16) {
            float bn[16], gt[16];
#pragma unroll
            for (int i = 0; i < 16; ++i) { bn[i] = BnT[(size_t)(n0 + i) * 2048]; gt[i] = Gt[(n0 + i) * 32]; }
#pragma unroll
            for (int i = 0; i < 16; ++i) { ST[(size_t)(n0 + i) * 2048] = f2bf(S); S = gt[i] * S + bn[i]; }
        }
    }
}

__device__ __forceinline__ void phase_m3(const KArgs& a, int l) {
    const int tid = opaque_tid(), lane = tid & 63, wave = tid >> 6, r = lane & 15, q = lane >> 4;
    const int gw = opaque_bid() * 8 + wave, NGW = gridDim.x * 8;
    const bf16* HP = (const bf16*)(a.ws + WS_HP); bf16* MIX = (bf16*)(a.ws + WS_MIX);
#pragma unroll 1
    for (int wi = gw; wi < 12288; wi += NGW) {
        f32x4 acc[4]; int row, zc, oc; const float* ng;
        if (wi < 8192) {
            const int unit = wi >> 2, it = wi & 3, b = unit >> 10, h = (unit >> 7) & 7, n = unit & 127;
            const bf16* Qd = (const bf16*)(a.ws + WS_QD) + (size_t)unit * 4096 + (16 * it + r) * 64;
            bf16x8 qa[2], pa[2];
#pragma unroll
            for (int ks = 0; ks < 2; ++ks) { qa[ks] = mk8(*(const u32x2*)(Qd + 32 * ks + 4 * q), *(const u32x2*)(Qd + 32 * ks + 16 + 4 * q));
                pa[ks] = as8(((const u32x4*)(a.ws + WS_PF))[((size_t)(unit * 4 + it) * 2 + ks) * 64 + lane]); }
#pragma unroll
            for (int dt = 0; dt < 4; ++dt) {
                f32x4 c = {0.f, 0.f, 0.f, 0.f};
#pragma unroll
                for (int ks = 0; ks < 2; ++ks) {
                    const bf16x8 sf = as8(((const u32x4*)(a.ws + WS_SP))[((size_t)(unit * 4 + dt) * 2 + ks) * 64 + lane]);
                    const bf16x8 uf = as8(((const u32x4*)(a.ws + WS_UF))[((size_t)(unit * 4 + dt) * 2 + ks) * 64 + lane]);
                    c = mfma16(sf, qa[ks], c); c = mfma16(uf, pa[ks], c);
                }
                acc[dt] = c;
            }
            row = b * SEQ + n * 64 + 16 * it + r; zc = C_BZ + h * 64; oc = 256 + h * 64; ng = a.in[14] + l * 64;
        } else {
            const int w2 = wi - 8192, unit = w2 >> 2, it = w2 & 3, b = unit >> 9, h = (unit >> 7) & 3, n = unit & 127;
            const bf16x8 qa = *(const bf16x8*)((const bf16*)(a.ws + WS_QDG) + (size_t)unit * 2048 + (16 * it + r) * 32 + 8 * q);
            const f32x4* OiT = (const f32x4*)(a.ws + WS_OIT) + (size_t)unit * 1024 + lane;
            const bf16* ST = (const bf16*)(a.ws + WS_ST) + (size_t)unit * 2048;
#pragma unroll
            for (int dt = 0; dt < 4; ++dt) {
                const bf16x8 sa = *(const bf16x8*)(ST + (16 * dt + r) * 32 + 8 * q);
#if GLA_DBG == 1
                acc[dt] = OiT[(it * 4 + dt) * 64];
#elif GLA_DBG == 2
                acc[dt] = mfma16(sa, qa, (f32x4){0.f, 0.f, 0.f, 0.f});
#else
                acc[dt] = mfma16(sa, qa, OiT[(it * 4 + dt) * 64]);
#endif
            }
            row = b * SEQ + n * 64 + 16 * it + r; zc = C_CR + h * 64; oc = 768 + h * 64; ng = a.in[17] + l * 64;
        }
        if ((wi < 8192) ? !(MIXSEL & 2) : !(MIXSEL & 4)) { for (int dt = 0; dt < 4; ++dt) acc[dt] = (f32x4){0.f, 0.f, 0.f, 0.f}; }
        float ss = 0.f;
#pragma unroll
        for (int dt = 0; dt < 4; ++dt) ss += (acc[dt][0] * acc[dt][0] + acc[dt][1] * acc[dt][1]) + (acc[dt][2] * acc[dt][2] + acc[dt][3] * acc[dt][3]);
        ss += __shfl_xor(ss, 16); ss += __shfl_xor(ss, 32);
        const float rs = rsqrtf(ss * (1.f / 64.f) + EPS);
#pragma unroll
        for (int dt = 0; dt < 4; ++dt) {
            const int d0 = 16 * dt + 4 * q;
            const u32x2 zv = *(const u32x2*)(HP + (size_t)row * DINP + zc + d0);
            const f32x4 gn = *(const f32x4*)(ng + d0);
            const float z0 = bflo(zv.x), z1 = bfhi(zv.x), z2 = bflo(zv.y), z3 = bfhi(zv.y);
            const float o0 = acc[dt][0] * rs * gn.x * z0 * sigm(z0), o1 = acc[dt][1] * rs * gn.y * z1 * sigm(z1), o2 = acc[dt][2] * rs * gn.z * z2 * sigm(z2), o3 = acc[dt][3] * rs * gn.w * z3 * sigm(z3);
            *(u32x2*)(MIX + (size_t)row * D + oc + d0) = (u32x2){pk2(o0, o1), pk2(o2, o3)};
        }
    }
}

typedef unsigned gu32;
#define XB_TMO      128
#define XB_XCNT(j)  (256  + 64 * (j))
#define XB_XSUB(j)  (1280 + 64 * (j))
#define XB_XGEN(j)  (2304 + 64 * (j))
#define XB_TOP      3328
#define XB_TOPGEN   3392
#define XCD_BAR_WORDS 3456
#define XB_SPIN_CAP (1u << 18)

__device__ __forceinline__ unsigned xb_ld(unsigned* p)              { return __hip_atomic_load(p, __ATOMIC_RELAXED, __HIP_MEMORY_SCOPE_AGENT); }
__device__ __forceinline__ unsigned xb_add(unsigned* p, unsigned v) { return __hip_atomic_fetch_add(p, v, __ATOMIC_RELAXED, __HIP_MEMORY_SCOPE_AGENT); }
__device__ __forceinline__ unsigned xb_xcc_id() { return (unsigned)__builtin_amdgcn_s_getreg((3 << 11) | 20) & 0xFu; }
#define XB_SPIN(cond, bar) do { unsigned _sp = 0; while (cond) { __builtin_amdgcn_s_sleep(1); \
    if ((++_sp & 255u) == 0u) { if (xb_ld(&(bar)[XB_TMO])) break; if (_sp > XB_SPIN_CAP) { atomicAdd(&(bar)[XB_TMO], 1u); break; } } } } while (0)

struct XcdBarrier {
    unsigned* bar; unsigned x;
    volatile LAS unsigned* st;
};

__device__ __forceinline__ XcdBarrier xcd_barrier_post(unsigned* bar, volatile LAS unsigned* st) {
    XcdBarrier b; b.bar = bar; b.x = xb_xcc_id(); b.st = st;
    if (threadIdx.x == 0) (void)xb_add(&bar[XB_XCNT(b.x)], 1u);
    return b;
}
__device__ __forceinline__ void xcd_barrier_complete(unsigned* bar, unsigned x, unsigned& nloc, unsigned& nx) {
    const unsigned G = gridDim.x * gridDim.y * gridDim.z;
    unsigned sum, cnt, mine, sp = 0u;
    for (;;) {
        sum = 0u; cnt = 0u; mine = 0u;
#pragma unroll
        for (unsigned j = 0; j < 16; ++j) { const unsigned c = xb_ld(&bar[XB_XCNT(j)]); sum += c; cnt += (c > 0u) ? 1u : 0u; mine = (j == x) ? c : mine; }
        if (sum == G) break;
        __builtin_amdgcn_s_sleep(1);
        if ((++sp & 255u) == 0u) { if (xb_ld(&bar[XB_TMO])) break; if (sp > XB_SPIN_CAP) { atomicAdd(&bar[XB_TMO], 1u); break; } }
    }
    nloc = mine > 0u ? mine : 1u; nx = cnt > 0u ? cnt : 1u;
}

__device__ __forceinline__ void xcd_barrier(const XcdBarrier& b) {
    asm volatile("s_waitcnt vmcnt(0)" ::: "memory");
    __syncthreads();
    if (threadIdx.x == 0) {
        unsigned* bar = b.bar;
        __builtin_amdgcn_s_waitcnt(0);
        unsigned nloc = b.st[0], nx = b.st[1];
        if (nloc == 0u) { xcd_barrier_complete(bar, b.x, nloc, nx); b.st[0] = nloc; b.st[1] = nx; }
        const unsigned old = xb_add(&bar[XB_XSUB(b.x)], 1u);
        const unsigned gen = old / nloc;
        if (old + 1u == (gen + 1u) * nloc) {
            __builtin_amdgcn_fence(__ATOMIC_RELEASE, "agent");
            asm volatile("s_waitcnt vmcnt(0)" ::: "memory");
            const unsigned og = xb_add(&bar[XB_TOP], 1u);
            const unsigned tg = og / nx;
            if (og + 1u == (tg + 1u) * nx) xb_add(&bar[XB_TOPGEN], 1u);
            else XB_SPIN(xb_ld(&bar[XB_TOPGEN]) == tg, bar);
            __builtin_amdgcn_fence(__ATOMIC_ACQUIRE, "agent");
            xb_add(&bar[XB_XGEN(b.x)], 1u);
            asm volatile("s_waitcnt vmcnt(0)" ::: "memory");
        } else {
            XB_SPIN(xb_ld(&bar[XB_XGEN(b.x)]) == gen, bar);
            __builtin_amdgcn_fence(__ATOMIC_ACQUIRE, "agent");
            asm volatile("s_waitcnt vmcnt(0)" ::: "memory");
        }
    }
    __syncthreads();
}

__global__ void __launch_bounds__(512, 2) mk_fwd(KArgs a) {
    extern __shared__ __attribute__((aligned(16))) unsigned char lds[];
    cg::grid_group grid = cg::this_grid();
    volatile LAS unsigned* MISC = (volatile LAS unsigned*)((LAS unsigned char*)lds + 131072);
    if (threadIdx.x < 16) MISC[threadIdx.x] = 0u;
    __syncthreads();
    XcdBarrier bar = xcd_barrier_post((unsigned*)(a.ws + WS_CTL) + 4096, MISC + 8);
    for (int ph = a.lo; ph < a.hi; ++ph) {
        const int l = ph / NPH, k = ph - l * NPH;
        unsigned char* ws = a.ws; asm volatile("" : "+s"(ws));
        const bf16* XB = (const bf16*)(ws + WS_XB); bf16* HB = (bf16*)(ws + WS_HP);
        if (k == 0) phase_conv(a, l, lds);
        else if (k == 1 || k == 10) {
            pg8::Gemm g{XB, (const bf16*)(ws + WS_W + (k == 1 ? OW13A : OW13B)), M, 2 * FF, D}; pg8::StaticOrder S; S.init(M, 2 * FF, gridDim.x, opaque_bid());
            pg8::EpiSwiglu E{HB, FF};
            pg8::gemm_phase<pg8::EpiSwiglu, pg8::StaticOrder, true, true>((LAS unsigned char*)lds, g, S, E);
        } else if (k == 2 || k == 11 || k == 8) {
            pg8::Gemm g; pg8::EpiRes E{a.out, D, ALPHA, 0.5f};
            if (k == 8) { g = pg8::Gemm{(const bf16*)(ws + WS_MIX), (const bf16*)(ws + WS_W + OWOUT), M, D, D}; E.cs = 1.0f; }
            else g = pg8::Gemm{HB, (const bf16*)(ws + WS_W + (k == 2 ? OW2A : OW2B)), M, D, FF};
            pg8::StaticOrder S; S.init(M, D, gridDim.x, opaque_bid());
            pg8::gemm_phase<pg8::EpiRes, pg8::StaticOrder, true, true>((LAS unsigned char*)lds, g, S, E);
        } else if (k == 3 || k == 9 || k == 12) {
            const int gi = (k == 3) ? 4 : (k == 9 ? 19 : 24);
            phase_ln(a, a.in[gi] + l * D, a.in[gi + 1] + l * D);
        } else if (k == 4) {
            pg8::Gemm g{XB, (const bf16*)(ws + WS_W + OWIN), M, DINP, D}; pg8::StaticOrder S; S.init(M, DINP, gridDim.x, opaque_bid());
            pg8::EpiProj E{HB, DINP, 2};
            pg8::gemm_phase<pg8::EpiProj, pg8::StaticOrder, true, true>((LAS unsigned char*)lds, g, S, E);
        } else if (k == 5) phase_m1(a, l, lds);
        else if (k == 6) phase_m2(a, lds);
        else phase_m3(a, l);
        if (ph + 1 < a.hi) { if (ph == a.lo) grid.sync(); else xcd_barrier(bar); }
    }
}

extern "C" void kernel_launch(void* const* d_in, const int* in_sizes, int n_in, void* d_out, int out_size, void* d_ws, size_t ws_size, hipStream_t stream) {
    static int grid = 0;
    if (grid == 0) {
        if (n_in != 26 || out_size != M * D || ws_size < WS_END) { fprintf(stderr, "kernel_launch: unexpected sizes n_in %d out %d ws %zu\n", n_in, out_size, ws_size); grid = -1; return; }
        int dev = 0, cus = 0;
        if (hipGetDevice(&dev) != hipSuccess || hipDeviceGetAttribute(&cus, hipDeviceAttributeMultiprocessorCount, dev) != hipSuccess) { grid = -1; return; }
        if (hipFuncSetAttribute((const void*)mk_fwd, hipFuncAttributeMaxDynamicSharedMemorySize, LDS_BYTES) != hipSuccess) { fprintf(stderr, "kernel_launch: hipFuncSetAttribute failed\n"); grid = -1; return; }
        grid = cus;
    }
    if (grid < 0) return;
    if (hipMemsetAsync((char*)d_ws + WS_CTL, 0, 1u << 20, stream) != hipSuccess) return;
    KArgs a{};
    for (int i = 0; i < 26; ++i) a.in[i] = (const float*)d_in[i];
    a.out = (float*)d_out; a.ws = (unsigned char*)d_ws;
#if ONE_LAUNCH
    a.lo = 0; a.hi = PH_HI;
    void* args[] = {&a};
    hipError_t e = hipLaunchCooperativeKernel((const void*)mk_fwd, dim3(grid), dim3(512), args, LDS_BYTES, stream);
    if (e != hipSuccess) fprintf(stderr, "cooperative launch failed: %s\n", hipGetErrorString(e));
#else
    for (int ph = 0; ph < PH_HI; ++ph) { a.lo = ph; a.hi = ph + 1; hipLaunchKernelGGL(mk_fwd, dim3(grid), dim3(512), LDS_BYTES, stream, a); }
#endif
}
```
